# Optimizing an MI355X kernel written in HIP

```python
import math
import jax, jax.numpy as jnp
from jax import lax
import numpy as np

D_MODEL = 1024
BATCH = 8
SEQ = 4096
DEPTH = 4
DEC_BATCH = 16
DEC_SEQ = 4096
PAST_LEN = 128

D_ATT = D_MODEL // 2
N_ATT_HEADS = 4
ATT_HEAD_DIM = D_ATT // N_ATT_HEADS
QK_DIM = ATT_HEAD_DIM // 2
D_GMLP = D_MODEL - D_ATT
N_GMLP_GROUPS = 4
GMLP_GROUP_DIM = D_GMLP // N_GMLP_GROUPS
CHUNK = 128
Q_BLOCK = 128
EPS = 1e-6
D_IN = 4 * D_ATT + 3 * D_GMLP
SPLITS = (D_ATT, 2 * D_ATT, 3 * D_ATT, 4 * D_ATT,
          4 * D_ATT + D_GMLP, 4 * D_ATT + 2 * D_GMLP)

kernel_name = "hymba_diffattn_gmlp_encoder"


def rmsnorm(x, g):
    xf = x.astype(jnp.float32)
    ms = jnp.mean(xf * xf, axis=-1, keepdims=True)
    return (xf * lax.rsqrt(ms + EPS) * g.astype(jnp.float32)).astype(x.dtype)


def alibi_slopes(n):
    return jnp.asarray(np.array([2.0 ** (-8.0 * (i + 1) / n) for i in range(n)], dtype=np.float32))


def lambda_init_fn(layer_idx):
    return 0.8 - 0.6 * math.exp(-0.3 * layer_idx)


def diff_attention(q, k, v, lam, lam_init, sub_g):
    B, S = q.shape[0], q.shape[1]
    nblk = S // Q_BLOCK
    scale = QK_DIM ** -0.5
    slopes = alibi_slopes(N_ATT_HEADS)
    pos = jnp.arange(S)
    qb = q.reshape(B, nblk, Q_BLOCK, N_ATT_HEADS, 2, QK_DIM).transpose(1, 0, 2, 3, 4, 5)

    def one_block(args):
        q_blk, blk = args
        t = blk * Q_BLOCK + jnp.arange(Q_BLOCK)
        dist = jnp.abs(t[:, None] - pos[None, :]).astype(jnp.float32)
        bias = -slopes[:, None, None] * dist
        s = jnp.einsum('bqhcd,bshcd->bhcqs', q_blk, k).astype(jnp.float32) * scale
        p = jax.nn.softmax(s + bias[None, :, None], axis=-1)
        a = p[:, :, 0] - lam * p[:, :, 1]
        return jnp.einsum('bhqs,bshe->bqhe', a.astype(v.dtype), v)

    o = lax.map(one_block, (qb, jnp.arange(nblk)))
    o = o.transpose(1, 0, 2, 3, 4).reshape(B, S, N_ATT_HEADS, ATT_HEAD_DIM)
    o = rmsnorm(o, sub_g) * (1.0 - lam_init)
    return o.reshape(B, S, D_ATT)


def spatial_gating(u, vg, vnorm_g, w_s, b_s):
    B, S = u.shape[0], u.shape[1]
    nc = S // CHUNK
    vn = rmsnorm(vg, vnorm_g).reshape(B, nc, CHUNK, N_GMLP_GROUPS, GMLP_GROUP_DIM)
    sv = jnp.einsum('gts,bcsgd->bctgd', w_s, vn) + b_s.T[None, None, :, :, None]
    return u * sv.reshape(B, S, D_GMLP)


def hybrid_layer(x, l, norm_g, w_in, lambda_qk, subln_g, vnorm_g, w_s, b_s, w_out):
    B, S = x.shape[0], x.shape[1]
    h = rmsnorm(x, norm_g[l])
    z = jnp.einsum('bsd,de->bse', h, w_in[l])
    zq, zk, zv, g_att, u, vg, g_gm = jnp.split(z, SPLITS, axis=-1)
    q = zq.reshape(B, S, N_ATT_HEADS, 2, QK_DIM)
    k = zk.reshape(B, S, N_ATT_HEADS, 2, QK_DIM)
    v = zv.reshape(B, S, N_ATT_HEADS, ATT_HEAD_DIM)
    lam_init = lambda_init_fn(l)
    lq = lambda_qk[l].astype(jnp.float32)
    lam = jnp.exp(jnp.sum(lq[0] * lq[1])) - jnp.exp(jnp.sum(lq[2] * lq[3])) + lam_init
    att = diff_attention(q, k, v, lam, lam_init, subln_g[l]) * jax.nn.silu(g_att)
    sgu = spatial_gating(u, vg, vnorm_g[l], w_s[l], b_s[l]) * jax.nn.silu(g_gm)
    y = jnp.einsum('bse,ed->bsd', jnp.concatenate([att, sgu], axis=-1), w_out[l])
    return x + y


def trunk(x, norm_g, w_in, lambda_qk, subln_g, vnorm_g, w_s, b_s, w_out, final_g):
    for l in range(DEPTH):
        x = hybrid_layer(x, l, norm_g, w_in, lambda_qk, subln_g, vnorm_g, w_s, b_s, w_out)
    return rmsnorm(x, final_g)


def setup_inputs(seed: int = 0) -> dict:
    key = jax.random.key(seed)
    ks = jax.random.split(key, 12)
    f32 = jnp.float32
    x_prompt = jax.random.normal(ks[0], (BATCH, SEQ, D_MODEL), f32)
    x_sample = jax.random.normal(ks[1], (DEC_BATCH, DEC_SEQ, D_MODEL), f32)
    norm_g = 1.0 + 0.02 * jax.random.normal(ks[2], (DEPTH, D_MODEL), f32)
    w_in = jax.random.normal(ks[3], (DEPTH, D_MODEL, D_IN), f32) * D_MODEL ** -0.5
    lambda_qk = 0.1 * jax.random.normal(ks[4], (DEPTH, 4, QK_DIM), f32)
    subln_g = 1.0 + 0.02 * jax.random.normal(ks[5], (DEPTH, ATT_HEAD_DIM), f32)
    vnorm_g = 1.0 + 0.02 * jax.random.normal(ks[6], (DEPTH, D_GMLP), f32)
    w_s = jax.random.normal(ks[7], (DEPTH, N_GMLP_GROUPS, CHUNK, CHUNK), f32) * CHUNK ** -0.5
    b_s = 1.0 + 0.1 * jax.random.normal(ks[8], (DEPTH, N_GMLP_GROUPS, CHUNK), f32)
    w_out = jax.random.normal(ks[9], (DEPTH, D_MODEL, D_MODEL), f32) * D_MODEL ** -0.5
    final_g = 1.0 + 0.02 * jax.random.normal(ks[10], (D_MODEL,), f32)
    return {"x_prompt": x_prompt, "x_sample": x_sample, "norm_g": norm_g, "w_in": w_in,
            "lambda_qk": lambda_qk, "subln_g": subln_g, "vnorm_g": vnorm_g, "w_s": w_s,
            "b_s": b_s, "w_out": w_out, "final_g": final_g}


def reference(x_prompt, x_sample, norm_g, w_in, lambda_qk, subln_g, vnorm_g, w_s, b_s, w_out, final_g):
    y_prompt = trunk(x_prompt, norm_g, w_in, lambda_qk, subln_g, vnorm_g, w_s, b_s, w_out, final_g)
    y_sample = trunk(x_sample, norm_g, w_in, lambda_qk, subln_g, vnorm_g, w_s, b_s, w_out, final_g)
    return (y_prompt, y_sample)
```

```cpp
#include <hip/hip_runtime.h>
#include <hip/hip_bf16.h>
#include <hip/hip_cooperative_groups.h>
#include <cstdio>
#include <cstdint>
#include <cmath>
namespace cg = cooperative_groups;
__device__ __forceinline__ int lane_now() { unsigned z; asm volatile("s_mov_b32 %0, 0" : "=s"(z)); return (int)__builtin_amdgcn_mbcnt_hi(~0u, __builtin_amdgcn_mbcnt_lo(~0u, z)); }
namespace pg8 {
#define PG8_LAS __attribute__((address_space(3)))
typedef unsigned short bf16_t;
typedef short bf16x8 __attribute__((ext_vector_type(8)));
typedef float f32x4 __attribute__((ext_vector_type(4)));
typedef unsigned u32x4 __attribute__((ext_vector_type(4)));
constexpr int BM = 256, BK = 64, HALF = 128, HTB = HALF * BK * 2  , STAGE_BYTES = 8 * HTB, NXCD = 8, WGM = 8;

__host__ __device__ __forceinline__ int lds_byte(int r, int c) { const int st = (r >> 4) * 2 + (c >> 5), rr = r & 15, cc = c & 31, ob = rr * 64 + cc * 2; return st * 1024 + (ob ^ (((ob >> 9) & 1) << 5)); }
__host__ __device__ __forceinline__ void stage_rc(int b, int& R, int& C) { const int st = b / 1024, sb = b % 1024, swz = sb ^ (((sb >> 9) & 1) << 5); R = (st >> 1) * 16 + swz / 64; C = (st & 1) * 32 + (swz % 64) / 2; }
__host__ __device__ __forceinline__ int perm32(int rho) { const int n = rho >> 4, i = rho & 15; return 8 * (i >> 2) + 4 * n + (i & 3); }

struct Unit { int pm, pn; };
struct Gemm { const bf16_t* A; const bf16_t* Bt; int M, N, K, lda, kjump; };

struct StaticOrder {
    int nM, nN, nwg, G, c;
    __host__ __device__ void init(int M, int N, int G_, int c_) { nM = M / BM; nN = N / BM; nwg = nM * nN; G = G_; c = c_; }
    __host__ __device__ bool next(int i, Unit& u) const {
        const long L = (long)i * G + c; if (L >= nwg) return false;
        int wgid = (int)L; { const int q = nwg / NXCD, r = nwg % NXCD, xcd = wgid % NXCD, off = wgid / NXCD; wgid = (xcd < r ? xcd * (q + 1) : r * (q + 1) + (xcd - r) * q) + off; }
        const int nig = WGM * nN, gid = wgid / nig, fm = gid * WGM, gsz = (nM - fm) < WGM ? (nM - fm) : WGM;
        u.pm = fm + ((wgid % nig) % gsz); u.pn = (wgid % nig) / gsz; return true;
    }
    __device__ __forceinline__ void a_ready(const Unit&) const {}
    __device__ __forceinline__ void done(const Unit&) const {}
};

__device__ __forceinline__ unsigned cvt_pk_bf16(float lo, float hi) { unsigned r; asm volatile("v_cvt_pk_bf16_f32 %0, %1, %2" : "=v"(r) : "v"(lo), "v"(hi)); return r; }
constexpr int SSQ_SHIFT = 24;
constexpr float SSQ_SCALE = 16777216.0f, SSQ_INV = 1.0f / 16777216.0f;
struct EpiZ {
    static constexpr bool PERM = true, AFTER_DRAIN = false;
    bf16_t* Z; const unsigned long long* ssq; float c2; unsigned* hmax;
    __device__ __forceinline__ void operator()(const f32x4 (&acc)[2][2][4][2], const Unit& u, int wr, int wc, int fr, int fq) const {
        const int row0 = u.pm * BM + wr * 64 + fr; const int col0 = u.pn * BM + wc * 32 + 8 * fq;
        const float sc = (u.pn < 2) ? c2 : 1.0f;
        float hm0 = 0.f, hm1 = 0.f;
        unsigned long long sq[8];
#pragma unroll
        for (int i = 0; i < 8; ++i) sq[i] = ssq[row0 + (i >> 2) * HALF + (i & 3) * 16];
#pragma unroll
        for (int ai = 0; ai < 2; ++ai)
#pragma unroll
            for (int m = 0; m < 4; ++m) { const int row = row0 + ai * HALF + m * 16;
                const float ms = (float)sq[ai * 4 + m] * (SSQ_INV / 1024.0f);
                const float rs = __builtin_amdgcn_rsqf(ms + 1e-6f) * sc;
                bf16_t* rowp = Z + (size_t)row * 3584 + col0;
#pragma unroll
                for (int bj = 0; bj < 2; ++bj) { const f32x4 v0 = acc[ai][bj][m][0] * rs, v1 = acc[ai][bj][m][1] * rs;
                    u32x4 w; w.x = cvt_pk_bf16(v0[0], v0[1]); w.y = cvt_pk_bf16(v0[2], v0[3]); w.z = cvt_pk_bf16(v1[0], v1[1]); w.w = cvt_pk_bf16(v1[2], v1[3]);
                    *(u32x4*)(rowp + bj * HALF) = w;
                    if (u.pn < 4) { float q = (v0[0] * v0[0] + v0[1] * v0[1]) + (v0[2] * v0[2] + v0[3] * v0[3]) + (v1[0] * v1[0] + v1[1] * v1[1]) + (v1[2] * v1[2] + v1[3] * v1[3]);
                        q += __shfl_xor(q, 16); q += __shfl_xor(q, 32); if (bj == 0) hm0 = __builtin_fmaxf(hm0, q); else hm1 = __builtin_fmaxf(hm1, q); } } }
        if (u.pn < 4) {
#pragma unroll
            for (int o = 1; o < 16; o <<= 1) { hm0 = __builtin_fmaxf(hm0, __shfl_xor(hm0, o)); hm1 = __builtin_fmaxf(hm1, __shfl_xor(hm1, o)); }
            if (fr == 0 && fq == 0) { unsigned* hp = hmax + (u.pm >> 4) * 32 + u.pn * 8 + wc; atomicMax(hp, __float_as_uint(hm0)); atomicMax(hp + 4, __float_as_uint(hm1)); } }
    }
};
struct EpiRes {
    static constexpr bool PERM = true, AFTER_DRAIN = false;
    bf16_t* xb; unsigned long long* ssqn; bool dry;
    __device__ __forceinline__ void operator()(const f32x4 (&acc)[2][2][4][2], const Unit& u, int wr, int wc, int fr, int fq) const {
        const int row0 = u.pm * BM + wr * 64 + fr; const int col0 = u.pn * BM + wc * 32 + 8 * fq;
        u32x4 pre[2][4][2];
#pragma unroll
        for (int ai = 0; ai < 2; ++ai)
#pragma unroll
            for (int m = 0; m < 4; ++m)
#pragma unroll
                for (int bj = 0; bj < 2; ++bj) pre[ai][m][bj] = *(const u32x4*)(xb + (size_t)(row0 + ai * HALF + m * 16) * 1024 + col0 + bj * HALF);
#pragma unroll
        for (int ai = 0; ai < 2; ++ai)
#pragma unroll
            for (int m = 0; m < 4; ++m) { const int row = row0 + ai * HALF + m * 16; const size_t off = (size_t)row * 1024 + col0; float ss = 0.f;
#pragma unroll
                for (int bj = 0; bj < 2; ++bj) { const u32x4 bw = pre[ai][m][bj];
                    const f32x4 b0 = {__uint_as_float(bw.x << 16), __uint_as_float(bw.x & 0xffff0000u), __uint_as_float(bw.y << 16), __uint_as_float(bw.y & 0xffff0000u)};
                    const f32x4 b1 = {__uint_as_float(bw.z << 16), __uint_as_float(bw.z & 0xffff0000u), __uint_as_float(bw.w << 16), __uint_as_float(bw.w & 0xffff0000u)};
                    const f32x4 v0 = acc[ai][bj][m][0] + b0, v1 = acc[ai][bj][m][1] + b1;
                    u32x4 w; w.x = cvt_pk_bf16(v0[0], v0[1]); w.y = cvt_pk_bf16(v0[2], v0[3]); w.z = cvt_pk_bf16(v1[0], v1[1]); w.w = cvt_pk_bf16(v1[2], v1[3]);
                    if (!dry) *(u32x4*)(xb + off + bj * HALF) = w;
                    ss += (v0[0] * v0[0] + v0[1] * v0[1]) + (v0[2] * v0[2] + v0[3] * v0[3]) + (v1[0] * v1[0] + v1[1] * v1[1]) + (v1[2] * v1[2] + v1[3] * v1[3]); }
                ss += __shfl_xor(ss, 16); ss += __shfl_xor(ss, 32);
                if (fq == 0 && (!dry || ss < 0.f)) atomicAdd(ssqn + row, (unsigned long long)(ss * SSQ_SCALE)); }
    }
};
template <class Epi, class Sched, bool ALIGN_EPI = false, bool SP2 = false>
__device__ __forceinline__ void gemm_phase(PG8_LAS unsigned char* lds, const Gemm g, const Sched& S, const Epi& E, const int wave_in) {
    int tid_ = wave_in * 64 + lane_now(); asm volatile("" : "+v"(tid_));
    const int tid = tid_, wid = __builtin_amdgcn_readfirstlane(tid >> 6), lane = tid & 63, wr = wid >> 2, wc = wid & 3, fr = lane & 15, fq = lane >> 4;
    const int K = g.K, nt = K / BK;
    unsigned voffA[2], voffB[2];
#pragma unroll
    for (int i = 0; i < 2; ++i) { int R, C; stage_rc(tid * 16 + i * 8192, R, C); const int Rb = Epi::PERM ? ((R & ~31) + perm32(R & 31)) : R;
        voffA[i] = (unsigned)(R * g.lda + C) * 2u; voffB[i] = (unsigned)(Rb * K + C) * 2u; }
    const size_t kstep = (size_t)(BK * 2);
    const size_t hstepA = (size_t)HALF * g.lda * 2, hstepB = (size_t)HALF * K * 2;
    const size_t tstepA = 2 * hstepA, tstepB = 2 * hstepB;
    const size_t kjump = (size_t)g.kjump;
#define PG8_KOFFA(t) ((size_t)(t) * kstep + ((t) >= 8 ? kjump : (size_t)0))
    const unsigned ldsw = (unsigned)wid * 1024u;
    const int aoff = lds_byte(wr * 64 + fr, fq * 8), boff = lds_byte(wc * 32 + fr, fq * 8);
#define PG8_SA(b, h) (((b) * 2 + (h)) * HTB)
#define PG8_SB(b, h) ((4 + (b) * 2 + (h)) * HTB)
#define PG8_STAGE(bufoff, gbase, voff) do { _Pragma("unroll") for (int _i = 0; _i < 2; ++_i) \
        __builtin_amdgcn_global_load_lds((const unsigned*)((const char*)(gbase) + (voff)[_i]), (PG8_LAS unsigned*)(lds + (bufoff) + ldsw + _i * 8192), 16, 0, 0); } while (0)
#define PG8_LDA(dst, b, h) do { _Pragma("unroll") for (int m = 0; m < 4; ++m) _Pragma("unroll") for (int k = 0; k < 2; ++k) dst[m][k] = *(const PG8_LAS bf16x8*)(lds + PG8_SA(b, h) + aoff + m * 2048 + k * 1024); } while (0)
#define PG8_LDB(dst, b, h) do { _Pragma("unroll") for (int n = 0; n < 2; ++n) _Pragma("unroll") for (int k = 0; k < 2; ++k) dst[n][k] = *(const PG8_LAS bf16x8*)(lds + PG8_SB(b, h) + boff + n * 2048 + k * 1024); } while (0)
#define PG8_MMA(ai, bj, At, Bt) do { __builtin_amdgcn_s_setprio(1); _Pragma("unroll") for (int m = 0; m < 4; ++m) _Pragma("unroll") for (int n = 0; n < 2; ++n) _Pragma("unroll") for (int k = 0; k < 2; ++k) \
        acc[ai][bj][m][n] = __builtin_amdgcn_mfma_f32_16x16x32_bf16(Bt[n][k], At[m][k], acc[ai][bj][m][n], 0, 0, 0); __builtin_amdgcn_s_setprio(0); } while (0)
#define PG8_WAIT_V(n) asm volatile("s_waitcnt vmcnt(" #n ")" ::: "memory")
#define PG8_WAIT_L(n) asm volatile("s_waitcnt lgkmcnt(" #n ")" ::: "memory")
#define PG8_BAR __builtin_amdgcn_s_barrier()
#define PG8_SCHED __builtin_amdgcn_sched_barrier(0)
    Unit cur, nxt; int ui = 0;
    if (!S.next(0, cur)) return;
    f32x4 acc[2][2][4][2];
#pragma unroll
    for (int a = 0; a < 2; ++a)
#pragma unroll
        for (int b = 0; b < 2; ++b)
#pragma unroll
            for (int m = 0; m < 4; ++m)
#pragma unroll
                for (int n = 0; n < 2; ++n) acc[a][b][m][n] = (f32x4){0.f, 0.f, 0.f, 0.f};
    bf16x8 At[4][2], B0[2][2], B1[2][2];
    const char* cA = (const char*)g.A + (size_t)cur.pm * tstepA; const char* cB = (const char*)g.Bt + (size_t)cur.pn * tstepB;
    S.a_ready(cur);
    if constexpr (SP2) {
        PG8_STAGE(PG8_SB(0, 0), cB, voffB); PG8_STAGE(PG8_SB(0, 1), cB + hstepB, voffB); PG8_STAGE(PG8_SA(0, 0), cA, voffA); PG8_STAGE(PG8_SA(0, 1), cA + hstepA, voffA);
        if (wr == 1) PG8_BAR;
        PG8_WAIT_V(2); PG8_BAR;
        PG8_STAGE(PG8_SB(1, 0), cB + kstep, voffB); PG8_STAGE(PG8_SA(1, 0), cA + kstep, voffA); PG8_STAGE(PG8_SB(1, 1), cB + hstepB + kstep, voffB);
        PG8_WAIT_V(6); PG8_BAR;
    } else {
        PG8_STAGE(PG8_SB(0, 0), cB, voffB); PG8_STAGE(PG8_SA(0, 0), cA, voffA); PG8_STAGE(PG8_SB(0, 1), cB + hstepB, voffB); PG8_STAGE(PG8_SA(0, 1), cA + hstepA, voffA);
        if (wr == 1) PG8_BAR;
        PG8_WAIT_V(4); PG8_BAR;
        PG8_STAGE(PG8_SB(1, 0), cB + kstep, voffB); PG8_STAGE(PG8_SA(1, 0), cA + kstep, voffA); PG8_STAGE(PG8_SB(1, 1), cB + hstepB + kstep, voffB);
        PG8_WAIT_V(6); PG8_BAR;
    }
    for (;;) {
        const bool has_next = S.next(ui + 1, nxt);
        const char* nA = has_next ? (const char*)g.A + (size_t)nxt.pm * tstepA : cA; const char* nB = has_next ? (const char*)g.Bt + (size_t)nxt.pn * tstepB : cB;
        for (int t = 0; t < nt; t += 2) {
            const bool last = (t == nt - 2);
            const char* a1 = cA + PG8_KOFFA(t + 1);
            const char* a2 = last ? nA : cA + PG8_KOFFA(t + 2); const char* b2 = last ? nB : cB + (size_t)(t + 2) * kstep;
            const char* a3 = a2 + kstep; const char* b3 = b2 + kstep;
            if (last && has_next) S.a_ready(nxt);
            if constexpr (SP2) {
            PG8_LDB(B0, 0, 0); PG8_LDB(B1, 0, 1); PG8_SCHED; PG8_LDA(At, 0, 0); PG8_STAGE(PG8_SA(1, 1), a1 + hstepA, voffA);
            PG8_WAIT_V(8); PG8_WAIT_L(0); PG8_BAR; PG8_MMA(0, 0, At, B0); PG8_MMA(0, 1, At, B1); PG8_BAR; PG8_SCHED;
            PG8_LDA(At, 0, 1); PG8_STAGE(PG8_SB(0, 0), b2, voffB); PG8_STAGE(PG8_SB(0, 1), b2 + hstepB, voffB); PG8_STAGE(PG8_SA(0, 0), a2, voffA);
            PG8_WAIT_V(8); PG8_WAIT_L(0); PG8_BAR; PG8_MMA(1, 0, At, B0); PG8_MMA(1, 1, At, B1); PG8_BAR; PG8_SCHED;
            PG8_LDB(B0, 1, 0); PG8_LDB(B1, 1, 1); PG8_SCHED; PG8_LDA(At, 1, 0); PG8_STAGE(PG8_SA(0, 1), a2 + hstepA, voffA);
            PG8_WAIT_V(8); PG8_WAIT_L(0); PG8_BAR; PG8_MMA(0, 0, At, B0); PG8_MMA(0, 1, At, B1); PG8_BAR; PG8_SCHED;
            PG8_LDA(At, 1, 1); PG8_STAGE(PG8_SB(1, 0), b3, voffB); PG8_STAGE(PG8_SB(1, 1), b3 + hstepB, voffB); PG8_STAGE(PG8_SA(1, 0), a3, voffA);
            PG8_WAIT_V(8); PG8_WAIT_L(0); PG8_BAR; PG8_MMA(1, 0, At, B0); PG8_MMA(1, 1, At, B1); PG8_BAR; PG8_SCHED;
            } else {
            PG8_LDB(B0, 0, 0); PG8_SCHED; PG8_LDA(At, 0, 0); PG8_STAGE(PG8_SA(1, 1), a1 + hstepA, voffA);
            PG8_WAIT_L(8); PG8_BAR; PG8_WAIT_L(0); PG8_MMA(0, 0, At, B0); PG8_BAR; PG8_SCHED;
            PG8_LDB(B1, 0, 1); PG8_STAGE(PG8_SB(0, 0), b2, voffB);
            PG8_BAR; PG8_WAIT_L(0); PG8_MMA(0, 1, At, B1); PG8_BAR;
            PG8_LDA(At, 0, 1); PG8_STAGE(PG8_SA(0, 0), a2, voffA);
            PG8_BAR; PG8_WAIT_L(0); PG8_MMA(1, 0, At, B0); PG8_BAR; PG8_SCHED;
            PG8_STAGE(PG8_SB(0, 1), b2 + hstepB, voffB);
            PG8_WAIT_V(6); PG8_BAR; PG8_MMA(1, 1, At, B1); PG8_BAR;
            PG8_LDB(B0, 1, 0); PG8_SCHED; PG8_LDA(At, 1, 0); PG8_STAGE(PG8_SA(0, 1), a2 + hstepA, voffA);
            PG8_WAIT_L(8); PG8_BAR; PG8_WAIT_L(0); PG8_MMA(0, 0, At, B0); PG8_BAR; PG8_SCHED;
            PG8_LDB(B1, 1, 1); PG8_STAGE(PG8_SB(1, 0), b3, voffB);
            PG8_BAR; PG8_WAIT_L(0); PG8_MMA(0, 1, At, B1); PG8_BAR;
            PG8_LDA(At, 1, 1); PG8_STAGE(PG8_SA(1, 0), a3, voffA);
            PG8_BAR; PG8_WAIT_L(0); PG8_MMA(1, 0, At, B0); PG8_BAR; PG8_SCHED;
            PG8_STAGE(PG8_SB(1, 1), b3 + hstepB, voffB);
            PG8_WAIT_V(6); PG8_BAR; PG8_MMA(1, 1, At, B1); PG8_BAR;
            }
        }
        if constexpr (ALIGN_EPI) { if (wr == 0) PG8_BAR; }
        if constexpr (!Epi::AFTER_DRAIN) { E(acc, cur, wr, wc, fr, fq); S.done(cur); }
        if (!has_next) break;
#pragma unroll
        for (int a = 0; a < 2; ++a)
#pragma unroll
            for (int b = 0; b < 2; ++b)
#pragma unroll
                for (int m = 0; m < 4; ++m)
#pragma unroll
                    for (int n = 0; n < 2; ++n) acc[a][b][m][n] = (f32x4){0.f, 0.f, 0.f, 0.f};
        cur = nxt; cA = nA; cB = nB; ++ui;
        if constexpr (ALIGN_EPI) { if (wr == 1) PG8_BAR; }
    }
    PG8_WAIT_V(0);
    if constexpr (!ALIGN_EPI) { if (wr == 0) PG8_BAR; }
    PG8_BAR;
    if constexpr (Epi::AFTER_DRAIN) { E.fused(acc, cur, wr, wc, fr, fq, lds, wid, lane); S.done(cur); }
#undef PG8_KOFFA
#undef PG8_SA
#undef PG8_SB
#undef PG8_STAGE
#undef PG8_LDA
#undef PG8_LDB
#undef PG8_MMA
#undef PG8_WAIT_V
#undef PG8_WAIT_L
#undef PG8_BAR
#undef PG8_SCHED
}
}
namespace mix {
#define LAS __attribute__((address_space(3)))
typedef unsigned short bf16_t;
typedef short bf16x8 __attribute__((ext_vector_type(8)));
typedef short s16x4 __attribute__((ext_vector_type(4)));
typedef short v4i16_t __attribute__((ext_vector_type(4)));
typedef float f32x16 __attribute__((ext_vector_type(16)));
typedef float f32x4 __attribute__((ext_vector_type(4)));
typedef unsigned u32x4 __attribute__((ext_vector_type(4)));
typedef unsigned u32x2 __attribute__((ext_vector_type(2)));
typedef float f32x2_t __attribute__((ext_vector_type(2))); typedef __bf16 bf16x2_t __attribute__((ext_vector_type(2)));
constexpr int ZP = 3584, SEQ = 4096;
constexpr int KBUF = 32768;
constexpr int EXP = 132;
constexpr int QF_OFF = 98304;
constexpr int WSF_OFF = 131072;
constexpr float LOG2E = 1.4426950408889634f;
__device__ __forceinline__ int crow(int r, int hi) { return (r & 3) + 8 * (r >> 2) + 4 * hi; }
__device__ __forceinline__ unsigned cvtpk(float lo, float hi) { f32x2_t v = {lo, hi}; bf16x2_t b = __builtin_convertvector(v, bf16x2_t); return __builtin_bit_cast(unsigned, b); }
__device__ __forceinline__ float bf2f(unsigned short b) { return __uint_as_float((unsigned)b << 16); }
__device__ __forceinline__ float bflo(unsigned w) { return __uint_as_float(w << 16); }
__device__ __forceinline__ float bfhi(unsigned w) { return __uint_as_float(w & 0xffff0000u); }
__device__ __forceinline__ s16x4 vtr(const LAS unsigned char* p) { return __builtin_bit_cast(s16x4, __builtin_amdgcn_ds_read_tr16_b64_v4i16((LAS v4i16_t*)p)); }
__device__ __forceinline__ float swap32(float v) { auto rr = __builtin_amdgcn_permlane32_swap(__float_as_uint(v), __float_as_uint(v), false, false); return (__builtin_amdgcn_mbcnt_lo(~0u, 0u) & 32) ? __uint_as_float(rr[0]) : __uint_as_float(rr[1]); }
__device__ __forceinline__ float silu(float x) { return x * __builtin_amdgcn_rcpf(1.0f + __builtin_amdgcn_exp2f(-x * LOG2E)); }
__device__ __forceinline__ unsigned vtr_off(int lane, int cc, int t) {
    const int hi = lane >> 5, blk = (lane >> 4) & 1, q4 = (lane & 15) >> 2, p = lane & 3;
    return 256u * (4 * hi + 8 * t + q4) + 16u * (((cc ^ q4) << 2) | ((2 * blk + (p >> 1)) ^ (hi + 2 * t))) + 8u * (p & 1);
}
__device__ __forceinline__ void glds16(const void* gsrc, unsigned lds_dst) { unsigned keep;
    asm volatile("s_mov_b32 %0, m0\n\ts_mov_b32 m0, %2\n\ts_nop 0\n\tglobal_load_lds_dwordx4 %1, off\n\ts_mov_b32 m0, %0" : "=&s"(keep) : "v"(gsrc), "s"(lds_dst) : "memory"); }
__device__ __forceinline__ unsigned vst_off(int row, int ch) { return 256u * row + 16u * (ch ^ (((row & 3) << 2) | ((row >> 2) & 3))); }

__device__ __forceinline__ int att_tile(int i, int d0, int nl) { const int j = i - 2; const int tl = d0 - 1 - j, tr = d0 + i - nl; int t = (j < nl) ? tl : tr; t = (i < 2) ? d0 + i : t; return t; }
__device__ __forceinline__ void attn_unit(LAS unsigned char* lds, bf16_t* Z, int b, int h, int qb, float slope2, float lam, float oml, const float* subg, const int wave_in, const int W, const bool first, const bool has_next, const int bN, const int hN, const int qbN, bool dry = false) {
    int tid_ = wave_in * 64 + lane_now(); asm volatile("" : "+v"(tid_));
    const int tid = tid_, lane = tid & 63, r32 = lane & 31, hi = lane >> 5; const int wid = __builtin_amdgcn_readfirstlane(tid >> 6);
    const int c = wid >> 2, qs = wid & 3;
    const size_t rowbase = (size_t)b * SEQ;
    LAS unsigned char* qlds = lds + QF_OFF + wid * 4096 + lane * 16;
    { const bf16_t* Qw = Z + (rowbase + qb * 128 + qs * 32 + r32) * ZP + h * 128 + c * 64 + hi * 8;
      bf16x8 qt[4];
#pragma unroll
      for (int s = 0; s < 4; ++s) qt[s] = *(const bf16x8*)(Qw + s * 16);
      asm volatile("" : "+v"(qt[0]), "+v"(qt[1]), "+v"(qt[2]), "+v"(qt[3]));
#pragma unroll
      for (int s = 0; s < 4; ++s) *(LAS bf16x8*)(qlds + s * 1024) = qt[s]; }
    const int vrow0 = 8 * wid + (lane >> 4), vrow1 = vrow0 + 4;
    const bf16_t* vg0 = Z + (rowbase + vrow0) * ZP + 1024 + h * 128 + ((lane & 15) ^ (((vrow0 & 3) << 2) | ((vrow0 >> 2) & 3))) * 8;
    const bf16_t* vg1 = Z + (rowbase + vrow1) * ZP + 1024 + h * 128 + ((lane & 15) ^ (((vrow1 & 3) << 2) | ((vrow1 >> 2) & 3))) * 8;
    const bf16_t* kg0 = vg0 - 512; const bf16_t* kg1 = vg1 - 512;
    unsigned kaddr[4], vaddr[4][2];
#pragma unroll
    for (int s = 0; s < 4; ++s) kaddr[s] = vst_off(r32, c * 8 + 2 * s + hi);
#pragma unroll
    for (int cc = 0; cc < 4; ++cc) { vaddr[cc][0] = 49152u + vtr_off(lane, cc, 0); vaddr[cc][1] = 49152u + vtr_off(lane, cc, 1); }
    LAS float* wsf = (LAS float*)(lds + WSF_OFF) + wid * 64;
    const unsigned lds0 = (unsigned)(uintptr_t)lds;
    const int q0w = qb * 128 + qs * 32, qpos = q0w + r32;
    bf16x8 kaug[2];
    { u32x4 w; w.y = hi ? 0x00003F80u : 0u; w.z = 0u; w.w = 0u;
      const unsigned k0b = __float_as_uint((float)r32) >> 16, k1b = __float_as_uint((float)(32 + r32)) >> 16;
      w.x = hi ? 0x3F803F80u : (k0b | (k0b << 16)); kaug[0] = __builtin_bit_cast(bf16x8, w);
      w.x = hi ? 0x3F803F80u : (k1b | (k1b << 16)); kaug[1] = __builtin_bit_cast(bf16x8, w); }
    unsigned slw;
    { const unsigned sh = cvtpk(slope2, 0.f) & 0xffffu; const float shf = __uint_as_float(sh << 16); const unsigned sl = cvtpk(slope2 - shf, 0.f) & 0xffffu; slw = sh | (sl << 16); }
    bf16x8 ones; { u32x4 w; w.x = w.y = w.z = w.w = 0x3F803F80u; ones = __builtin_bit_cast(bf16x8, w); }
    f32x16 ol = f32x16{};
    const int d0 = 2 * qb;
    float mhat = 0.f; f32x16 o[4]; const f32x16 zero16 = f32x16{};
#pragma unroll
    for (int cc = 0; cc < 4; ++cc) o[cc] = f32x16{};
    const int nl = (d0 < W) ? d0 : W, nr = (62 - d0 < W) ? 62 - d0 : W, NT = 2 + nl + nr;
#define ATT_TILE(i) att_tile((i), d0, nl)
#define ATT_DMAK_(k0p, k1p, tile, slot) do { const size_t go = (size_t)(tile) * 64 * ZP; const unsigned bb = lds0 + (slot) * 16384 + wid * 2048; \
        glds16((k0p) + go, (unsigned)__builtin_amdgcn_readfirstlane(bb)); glds16((k1p) + go, (unsigned)__builtin_amdgcn_readfirstlane(bb + 1024)); } while (0)
#define ATT_DMAK(tile, slot) ATT_DMAK_(kg0, kg1, tile, slot)
#define ATT_DMAV_(v0p, v1p, tile, slot) do { const size_t go = (size_t)(tile) * 64 * ZP; const unsigned bb = lds0 + 49152 + (slot) * 16384 + wid * 2048; \
        glds16((v0p) + go, (unsigned)__builtin_amdgcn_readfirstlane(bb)); glds16((v1p) + go, (unsigned)__builtin_amdgcn_readfirstlane(bb + 1024)); } while (0)
#define ATT_DMAV(tile, slot) ATT_DMAV_(vg0, vg1, tile, slot)
#define ATT_BAR() do { asm volatile("s_waitcnt vmcnt(0)" ::: "memory"); __syncthreads(); } while (0)
#define ATT_BAR4() do { asm volatile("s_waitcnt vmcnt(4)" ::: "memory"); __syncthreads(); } while (0)
#define MX3(a, b, c) __builtin_fmaxf(__builtin_fmaxf((a), (b)), (c))
#define ATT_QAUG(dst, kvs) do { const float sg_ = ((kvs) <= q0w) ? 1.0f : -1.0f; const float x_ = __builtin_fmaf(sg_ * slope2, (float)((tile_) * 64 - qpos), -mhat); \
        const unsigned wa_ = cvtpk(x_, x_); const float r1_ = x_ - __uint_as_float(wa_ & 0xffff0000u); const unsigned wb_ = cvtpk(r1_, r1_); const float r2_ = r1_ - __uint_as_float(wb_ & 0xffff0000u); \
        const unsigned wc_ = cvtpk(r2_, 0.f); u32x4 w_; w_.x = hi ? ((wa_ & 0xffffu) | (wb_ & 0xffff0000u)) : (((kvs) <= q0w) ? slw : (slw ^ 0x80008000u)); w_.y = hi ? wc_ : 0u; w_.z = 0u; w_.w = 0u; dst = __builtin_bit_cast(bf16x8, w_); } while (0)
#define ATT_QK(tile, kslot) do { const int tile_ = (tile); const LAS unsigned char* kb_ = lds + (kslot) * 16384; bf16x8 kf_[8]; \
        _Pragma("unroll") for (int s = 0; s < 4; ++s) { kf_[2 * s] = *(const LAS bf16x8*)(kb_ + kaddr[s]); kf_[2 * s + 1] = *(const LAS bf16x8*)(kb_ + kaddr[s] + 8192); } \
        bf16x8 qf[4]; _Pragma("unroll") for (int s = 0; s < 4; ++s) qf[s] = *(const LAS bf16x8*)(qlds + s * 1024); \
        bf16x8 qa0_, qa1_; ATT_QAUG(qa0_, tile_ * 64); ATT_QAUG(qa1_, tile_ * 64 + 32); \
        s0 = __builtin_amdgcn_mfma_f32_32x32x16_bf16(kaug[0], qa0_, zero16, 0, 0, 0); s1 = __builtin_amdgcn_mfma_f32_32x32x16_bf16(kaug[1], qa1_, zero16, 0, 0, 0); \
        _Pragma("unroll") for (int s = 0; s < 4; ++s) { s0 = __builtin_amdgcn_mfma_f32_32x32x16_bf16(kf_[2 * s], qf[s], s0, 0, 0, 0); s1 = __builtin_amdgcn_mfma_f32_32x32x16_bf16(kf_[2 * s + 1], qf[s], s1, 0, 0, 0); } \
        if (tile_ == d0 + (qs >> 1)) { const float m2_ = -2.0f * slope2; \
            if (qs & 1) { _Pragma("unroll") for (int r = 0; r < 16; ++r) s1[r] = __builtin_fmaf(m2_, __builtin_fmaxf((float)(crow(r, hi) - r32), 0.f), s1[r]); } \
            else { _Pragma("unroll") for (int r = 0; r < 16; ++r) s0[r] = __builtin_fmaf(m2_, __builtin_fmaxf((float)(crow(r, hi) - r32), 0.f), s0[r]); } } } while (0)
#define ATT_ROWMAX(rm) do { float a_ = MX3(s0[0], s0[1], s1[0]), b_ = MX3(s0[2], s0[3], s1[1]); a_ = MX3(a_, s1[2], s1[3]); \
        _Pragma("unroll") for (int r = 4; r < 16; r += 4) { a_ = MX3(a_, s0[r], s0[r + 1]); b_ = MX3(b_, s0[r + 2], s0[r + 3]); a_ = MX3(a_, s1[r], s1[r + 1]); b_ = MX3(b_, s1[r + 2], s1[r + 3]); } \
        rm = __builtin_fmaxf(a_, b_); rm = __builtin_fmaxf(rm, swap32(rm)); } while (0)
#define ATT_RESC_CHECK(rm) do { if (__any(rm > 8.0f)) { const float dl = __builtin_fmaxf(rm, 0.f); mhat += dl; \
        _Pragma("unroll") for (int r = 0; r < 16; ++r) { s0[r] -= dl; s1[r] -= dl; } \
        const float f = __builtin_amdgcn_exp2f(-dl); wsf[r32] = f; resc = true; } } while (0)
#define ATT_EXP_PACK() do { \
        _Pragma("unroll") for (int r = 0; r < 16; ++r) { s0[r] = __builtin_amdgcn_exp2f(s0[r]); s1[r] = __builtin_amdgcn_exp2f(s1[r]); } \
        u32x4 w; \
        w.x = cvtpk(s0[0], s0[1]); w.y = cvtpk(s0[2], s0[3]); w.z = cvtpk(s0[4], s0[5]); w.w = cvtpk(s0[6], s0[7]); pf[0] = __builtin_bit_cast(bf16x8, w); \
        w.x = cvtpk(s0[8], s0[9]); w.y = cvtpk(s0[10], s0[11]); w.z = cvtpk(s0[12], s0[13]); w.w = cvtpk(s0[14], s0[15]); pf[1] = __builtin_bit_cast(bf16x8, w); \
        w.x = cvtpk(s1[0], s1[1]); w.y = cvtpk(s1[2], s1[3]); w.z = cvtpk(s1[4], s1[5]); w.w = cvtpk(s1[6], s1[7]); pf[2] = __builtin_bit_cast(bf16x8, w); \
        w.x = cvtpk(s1[8], s1[9]); w.y = cvtpk(s1[10], s1[11]); w.z = cvtpk(s1[12], s1[13]); w.w = cvtpk(s1[14], s1[15]); pf[3] = __builtin_bit_cast(bf16x8, w); } while (0)
#define ATT_RESC_APPLY() do { if (resc) { asm volatile("s_waitcnt lgkmcnt(0)" ::: "memory"); __builtin_amdgcn_wave_barrier(); \
        _Pragma("unroll") for (int k = 0; k < 4; ++k) { const f32x4 fv_ = *(const LAS f32x4*)(wsf + 8 * k + 4 * hi); \
            _Pragma("unroll") for (int cc = 0; cc < 4; ++cc) { o[cc][4 * k + 0] *= fv_[0]; o[cc][4 * k + 1] *= fv_[1]; o[cc][4 * k + 2] *= fv_[2]; o[cc][4 * k + 3] *= fv_[3]; } \
            ol[4 * k + 0] *= fv_[0]; ol[4 * k + 1] *= fv_[1]; ol[4 * k + 2] *= fv_[2]; ol[4 * k + 3] *= fv_[3]; } \
        asm volatile("s_waitcnt lgkmcnt(0)" ::: "memory"); __builtin_amdgcn_wave_barrier(); } } while (0)
#define ATT_VRD(dst, vb_, cc) do { _Pragma("unroll") for (int ks = 0; ks < 4; ++ks) { dst[2 * ks] = vtr(vb_ + vaddr[cc][0] + ks * 4096); dst[2 * ks + 1] = vtr(vb_ + vaddr[cc][1] + ks * 4096); } } while (0)
#define ATT_VF(src, ks) (bf16x8){src[2 * (ks)][0], src[2 * (ks)][1], src[2 * (ks)][2], src[2 * (ks)][3], src[2 * (ks) + 1][0], src[2 * (ks) + 1][1], src[2 * (ks) + 1][2], src[2 * (ks) + 1][3]}
#define ATT_PV(cc, src) do { _Pragma("unroll") for (int ks = 0; ks < 4; ++ks) o[cc] = __builtin_amdgcn_mfma_f32_32x32x16_bf16(pf[ks], ATT_VF(src, ks), o[cc], 0, 0, 0); } while (0)
    f32x16 s0, s1; bf16x8 pf[4]; bool resc = false;
    if (c == 0) __builtin_amdgcn_s_setprio(1);
    {
        if (first) { ATT_DMAK(ATT_TILE(0), 0); ATT_DMAV(ATT_TILE(0), 0); ATT_DMAK(ATT_TILE(1), 1); }
        { const int i2 = (2 < NT) ? 2 : NT - 1; const int t2 = ATT_TILE(i2); ATT_DMAK(t2, 2); ATT_DMAV(ATT_TILE(1), 1); } }
    ATT_BAR4();
    { ATT_QK(ATT_TILE(0), 0); float rm; ATT_ROWMAX(rm); ATT_RESC_CHECK(rm); ATT_EXP_PACK(); resc = false; }
    ATT_BAR();
#define ATT_PVC(cc, src) do { _Pragma("unroll") for (int ks = 0; ks < 4; ++ks) o[cc] = __builtin_amdgcn_mfma_f32_32x32x16_bf16(pc[ks], ATT_VF(src, ks), o[cc], 0, 0, 0); } while (0)
#define ATT_LSUM() do { _Pragma("unroll") for (int ks = 0; ks < 4; ++ks) ol = __builtin_amdgcn_mfma_f32_32x32x16_bf16(pc[ks], ones, ol, 0, 0, 0); } while (0)
    int m3 = 0;
    for (int i = 0; i < NT - 1; ++i) {
        const int m3p1 = (m3 == 2) ? 0 : m3 + 1, m3p2 = (m3 == 0) ? 2 : m3 - 1;
        { const int i3 = __builtin_elementwise_min(i + 3, NT - 1); const int t3 = ATT_TILE(i3); ATT_DMAK(t3, m3); }
        { const int i2 = __builtin_elementwise_min(i + 2, NT - 1); const int t2 = ATT_TILE(i2); ATT_DMAV(t2, m3p2); }
        const int t1 = ATT_TILE(i + 1);
        const LAS unsigned char* vb = lds + m3 * 16384;
        s16x4 va[8], vbb[8];
        bf16x8 pc[4];
#pragma unroll
        for (int k = 0; k < 4; ++k) pc[k] = pf[k];
        ATT_VRD(va, vb, 0);
        ATT_QK(t1, m3p1);
        ATT_VRD(vbb, vb, 1);
        float rm; ATT_ROWMAX(rm); ATT_RESC_CHECK(rm);
        ATT_PVC(0, va);
        ATT_VRD(va, vb, 2);
        ATT_PVC(1, vbb);
        ATT_VRD(vbb, vb, 3);
        ATT_EXP_PACK();
        ATT_PVC(2, va);
        ATT_LSUM();
        ATT_PVC(3, vbb);
        asm volatile("" : "+v"(pf[0]), "+v"(pf[1]), "+v"(pf[2]), "+v"(pf[3]));
#pragma unroll
        for (int g_ = 0; g_ < 20; ++g_) { __builtin_amdgcn_sched_group_barrier(0x008, 1, 0); __builtin_amdgcn_sched_group_barrier(0x002, 3, 0); __builtin_amdgcn_sched_group_barrier(0x100, 1, 0); }
        ATT_RESC_APPLY(); resc = false;
        ATT_BAR4();
        m3 = m3p1;
    }
    {
        const LAS unsigned char* vb = lds + m3 * 16384;
        s16x4 va[8], vbb[8]; bf16x8 pc[4];
#pragma unroll
        for (int k = 0; k < 4; ++k) pc[k] = pf[k];
        ATT_VRD(va, vb, 0); ATT_VRD(vbb, vb, 1); ATT_PVC(0, va); ATT_VRD(va, vb, 2); ATT_PVC(1, vbb); ATT_VRD(vbb, vb, 3); ATT_PVC(2, va); ATT_LSUM(); ATT_PVC(3, vbb);
        ATT_BAR();
    }
    __builtin_amdgcn_s_setprio(0);
    if (has_next) {
        const size_t rbN = (size_t)bN * SEQ; const int d0N = 2 * qbN;
        const bf16_t* vgN0 = Z + (rbN + vrow0) * ZP + 1024 + hN * 128 + ((lane & 15) ^ (((vrow0 & 3) << 2) | ((vrow0 >> 2) & 3))) * 8;
        const bf16_t* vgN1 = Z + (rbN + vrow1) * ZP + 1024 + hN * 128 + ((lane & 15) ^ (((vrow1 & 3) << 2) | ((vrow1 >> 2) & 3))) * 8;
        ATT_DMAK_(vgN0 - 512, vgN1 - 512, d0N, 0); ATT_DMAV_(vgN0, vgN1, d0N, 0); ATT_DMAK_(vgN0 - 512, vgN1 - 512, d0N + 1, 1);
    }
#undef ATT_TILE
#undef ATT_DMAK
#undef ATT_DMAK_
#undef ATT_DMAV_
#undef ATT_BAR
#undef ATT_BAR4
#undef ATT_DMAV
#undef ATT_QK
#undef ATT_ROWMAX
#undef ATT_RESC_CHECK
#undef ATT_EXP_PACK
#undef ATT_RESC_APPLY
#undef ATT_VRD
#undef ATT_VF
#undef ATT_PV
#undef ATT_PVC
#undef ATT_LSUM
#undef ATT_QAUG
#undef MX3
    u32x2 gpre[8];
#pragma unroll
    for (int it = 0; it < 8; ++it) gpre[it] = *(const u32x2*)(Z + (rowbase + qb * 128 + wid * 16 + 2 * it + hi) * ZP + h * 128 + 4 * r32 + 1536);
    f32x4 fv[4];
    { const float lc = (c == 0) ? 1.0f : -lam;
#pragma unroll
      for (int k = 0; k < 4; ++k) { fv[k][0] = lc * __builtin_amdgcn_rcpf(ol[4 * k + 0]); fv[k][1] = lc * __builtin_amdgcn_rcpf(ol[4 * k + 1]); fv[k][2] = lc * __builtin_amdgcn_rcpf(ol[4 * k + 2]); fv[k][3] = lc * __builtin_amdgcn_rcpf(ol[4 * k + 3]); } }
    LAS float* Ex = (LAS float*)(lds + 65536);
    if (c == 1) {
#pragma unroll
        for (int cc = 0; cc < 4; ++cc)
#pragma unroll
            for (int r = 0; r < 16; ++r) Ex[(qs * 32 + crow(r, hi)) * EXP + cc * 32 + r32] = o[cc][r] * fv[r >> 2][r & 3];
    }
    __syncthreads();
    if (c == 0) {
#pragma unroll
        for (int cc = 0; cc < 4; ++cc)
#pragma unroll
            for (int r = 0; r < 16; ++r) { LAS float* p = Ex + (qs * 32 + crow(r, hi)) * EXP + cc * 32 + r32; *p = *p + o[cc][r] * fv[r >> 2][r & 3]; }
    }
    __syncthreads();
    { const f32x4 sg = *(const f32x4*)(subg + 4 * r32);
#pragma unroll
      for (int it = 0; it < 8; ++it) { const int row = wid * 16 + 2 * it + hi;
        const f32x4 v = *(const LAS f32x4*)(Ex + row * EXP + 4 * r32);
        float ss = (v[0] * v[0] + v[1] * v[1]) + (v[2] * v[2] + v[3] * v[3]);
        ss += __shfl_xor(ss, 1); ss += __shfl_xor(ss, 2); ss += __shfl_xor(ss, 4); ss += __shfl_xor(ss, 8); ss += __shfl_xor(ss, 16);
        const float rs = __builtin_amdgcn_rsqf(ss * (1.0f / 128.0f) + 1e-6f) * oml;
        bf16_t* zr = Z + (rowbase + qb * 128 + row) * ZP + h * 128 + 4 * r32;
        const u32x2 gw = gpre[it];
        const float o0 = v[0] * rs * sg[0] * silu(bflo(gw.x)), o1 = v[1] * rs * sg[1] * silu(bfhi(gw.x)), o2 = v[2] * rs * sg[2] * silu(bflo(gw.y)), o3 = v[3] * rs * sg[3] * silu(bfhi(gw.y));
        u32x2 ow; ow.x = cvtpk(o0, o1); ow.y = cvtpk(o2, o3); if (!dry) *(u32x2*)zr = ow; } }
    __syncthreads();
}

__device__ __forceinline__ void sgu_unit(LAS unsigned char* lds, bf16_t* Z, int b, int chunk, const float* vng, const bf16_t* Wsb, const float* bs, const int wave_in, bool dry = false) {
    int tid_ = wave_in * 64 + lane_now(); asm volatile("" : "+v"(tid_));
    const int tid = tid_, lane = tid & 63, r32 = lane & 31, hi = lane >> 5; const int wid = __builtin_amdgcn_readfirstlane(tid >> 6);
    const size_t rowbase = (size_t)b * SEQ + (size_t)chunk * 128;
    { f32x4 g0 = *(const f32x4*)(vng + lane * 8), g1 = *(const f32x4*)(vng + lane * 8 + 4);
#pragma unroll 8
      for (int it = 0; it < 16; ++it) { const int row = wid * 16 + it;
        const u32x4 raw = *(const u32x4*)(Z + (rowbase + row) * ZP + 2560 + lane * 8);
        float x[8] = {bflo(raw.x), bfhi(raw.x), bflo(raw.y), bfhi(raw.y), bflo(raw.z), bfhi(raw.z), bflo(raw.w), bfhi(raw.w)};
        float ss = 0.f;
#pragma unroll
        for (int j = 0; j < 8; ++j) ss += x[j] * x[j];
#pragma unroll
        for (int of = 1; of < 64; of <<= 1) ss += __shfl_xor(ss, of);
        const float rs = __builtin_amdgcn_rsqf(ss * (1.0f / 512.0f) + 1e-6f);
        u32x4 w; w.x = cvtpk(x[0] * rs * g0[0], x[1] * rs * g0[1]); w.y = cvtpk(x[2] * rs * g0[2], x[3] * rs * g0[3]); w.z = cvtpk(x[4] * rs * g1[0], x[5] * rs * g1[1]); w.w = cvtpk(x[6] * rs * g1[2], x[7] * rs * g1[3]);
        *(LAS u32x4*)(lds + (lane >> 4) * 32768 + vst_off(row, lane & 15)) = w; } }
    __syncthreads();
    const int tb = wid & 3, dh = wid >> 2;
    unsigned va[2][2];
#pragma unroll
    for (int c2 = 0; c2 < 2; ++c2) { va[c2][0] = vtr_off(lane, dh * 2 + c2, 0); va[c2][1] = vtr_off(lane, dh * 2 + c2, 1); }
    for (int g = 0; g < 4; ++g) {
        bf16x8 af[8];
        { const bf16_t* wp = Wsb + ((size_t)(g * 128 + tb * 32 + r32)) * 128 + 4 * hi;
#pragma unroll
          for (int ks = 0; ks < 8; ++ks) { const u32x2 lo = *(const u32x2*)(wp + 16 * ks), hh = *(const u32x2*)(wp + 16 * ks + 8); u32x4 w; w.x = lo.x; w.y = lo.y; w.z = hh.x; w.w = hh.y; af[ks] = __builtin_bit_cast(bf16x8, w); } }
        f32x16 acc[2]; acc[0] = f32x16{}; acc[1] = f32x16{};
        const LAS unsigned char* tbp = lds + g * 32768;
#pragma unroll
        for (int c2 = 0; c2 < 2; ++c2)
#pragma unroll
            for (int ks = 0; ks < 8; ++ks) { const s16x4 lo = vtr(tbp + va[c2][0] + ks * 4096), hh = vtr(tbp + va[c2][1] + ks * 4096);
                const bf16x8 vf = (bf16x8){lo[0], lo[1], lo[2], lo[3], hh[0], hh[1], hh[2], hh[3]};
                acc[c2] = __builtin_amdgcn_mfma_f32_32x32x16_bf16(af[ks], vf, acc[c2], 0, 0, 0); }
        unsigned short uu_[2][16], gg_[2][16];
#pragma unroll
        for (int c2 = 0; c2 < 2; ++c2)
#pragma unroll
            for (int r = 0; r < 16; ++r) { const int t = tb * 32 + crow(r, hi); const int col = g * 128 + (dh * 2 + c2) * 32 + r32;
                const bf16_t* zp = Z + (rowbase + t) * ZP + 2048 + col; uu_[c2][r] = zp[0]; gg_[c2][r] = zp[1024]; }
#pragma unroll
        for (int c2 = 0; c2 < 2; ++c2)
#pragma unroll
            for (int r = 0; r < 16; ++r) { const int t = tb * 32 + crow(r, hi); const int col = g * 128 + (dh * 2 + c2) * 32 + r32;
                bf16_t* zp = Z + (rowbase + t) * ZP + 2048 + col;
                const float sv = acc[c2][r] + bs[g * 128 + t];
                const float ov = bf2f(uu_[c2][r]) * sv * silu(bf2f(gg_[c2][r]));
                if (!dry) zp[0] = (bf16_t)(cvtpk(ov, 0.f) & 0xffffu); }
    }
    __syncthreads();
}
#undef LAS
}
#define LAS __attribute__((address_space(3)))
typedef unsigned short bf16;
typedef unsigned v4u __attribute__((ext_vector_type(4)));
typedef float f32x4 __attribute__((ext_vector_type(4)));
constexpr int NWAVES = 8, NTHREADS = 512;
constexpr int DM = 1024, DIN = 3584, DEPTH = 4, SEQ = 4096, NB_P = 8, NB_S = 16, NB = 24;
constexpr int M = NB * SEQ;
constexpr int M_P = NB_P * SEQ;
constexpr size_t MiB = 1u << 20;
constexpr size_t WS_MISC = 0;
constexpr size_t WS_HMAX = 65536;
constexpr size_t WS_WIN = 1 * MiB;
constexpr size_t WS_WOUT = 30 * MiB;
constexpr size_t WS_WS = 39 * MiB;
constexpr size_t WS_SSQ = 40 * MiB;
constexpr size_t WS_XB = 44 * MiB;
constexpr size_t WS_Z = 240 * MiB;
constexpr size_t WS_END = WS_Z + (size_t)M * DIN * 2;
static_assert(WS_XB + (size_t)M * DM * 2 <= WS_Z && WS_END <= (size_t)1024 * MiB, "d_ws map");
constexpr int LDS_BYTES = 139264;

__device__ __forceinline__ unsigned f2bf(float f) { unsigned u = __builtin_bit_cast(unsigned, f); return (u + 0x7fffu + ((u >> 16) & 1u)) >> 16; }
__device__ __forceinline__ unsigned pk2(float lo, float hi) { return f2bf(lo) | (f2bf(hi) << 16); }
__device__ __forceinline__ float wave_sum(float v) {
#pragma unroll
    for (int o = 1; o < 64; o <<= 1) v += __shfl_xor(v, o);
    return v;
}
__device__ __forceinline__ void transpose_item(const float* W, int K, int N, bf16* WT, const float* gsc, LAS float* scr, int item, int lane) {
    const int nblk = N / 32, kb = item / nblk, nb = item % nblk, k0 = 64 * kb, n0 = 32 * nb;
#pragma unroll 8
    for (int i = 0; i < 32; ++i) { const int kk = 2 * i + (lane >> 5); const float sc = gsc ? gsc[k0 + kk] : 1.0f; scr[kk * 33 + (lane & 31)] = W[(size_t)(k0 + kk) * N + n0 + (lane & 31)] * sc; }
    asm volatile("s_waitcnt lgkmcnt(0)" ::: "memory");
    const int c = lane & 7;
#pragma unroll
    for (int j = 0; j < 4; ++j) { const int n = (lane >> 3) + 8 * j; const LAS float* s = scr + (8 * c) * 33 + n;
        v4u o; o.x = pk2(s[0 * 33], s[1 * 33]); o.y = pk2(s[2 * 33], s[3 * 33]); o.z = pk2(s[4 * 33], s[5 * 33]); o.w = pk2(s[6 * 33], s[7 * 33]);
        *(v4u*)(WT + (size_t)(n0 + n) * K + k0 + 8 * c) = o; }
    asm volatile("s_waitcnt lgkmcnt(0)" ::: "memory");
}

struct Args { const float* xp; const float* xs; const float* norm_g; const float* w_in; const float* lambda_qk; const float* subln_g; const float* vnorm_g;
              const float* w_s; const float* b_s; const float* w_out; const float* final_g; float* out; unsigned char* ws; };

__global__ void __launch_bounds__(NTHREADS) hymba_fwd(Args a) {
    extern __shared__ __attribute__((aligned(16))) unsigned char lds_raw[];
    LAS unsigned char* lds = (LAS unsigned char*)lds_raw;
    cg::grid_group grid = cg::this_grid();
    const int tid = threadIdx.x, lane = tid & 63; const int wave = __builtin_amdgcn_readfirstlane(tid >> 6);
    const int G = gridDim.x, bx = blockIdx.x;
    const int vcu = (G % 8 == 0) ? (bx % 8) * (G / 8) + bx / 8 : bx;
    unsigned char* ws = a.ws;
    float* misc = (float*)(ws + WS_MISC);
    unsigned* hmax = (unsigned*)(ws + WS_HMAX);
    bf16* WinT = (bf16*)(ws + WS_WIN); bf16* WoutT = (bf16*)(ws + WS_WOUT); bf16* Wsb = (bf16*)(ws + WS_WS);
    unsigned long long* ssq = (unsigned long long*)(ws + WS_SSQ);
    bf16* XB = (bf16*)(ws + WS_XB); bf16* Z = (bf16*)(ws + WS_Z);

    {
        const int gw = vcu * NWAVES + wave, NGW = G * NWAVES;
        LAS float* scr = (LAS float*)(lds + wave * 16384);
        constexpr int I_IN = (DM / 64) * (DIN / 32), I_OUT = (DM / 64) * (DM / 32), I_L = I_IN + I_OUT;
        for (int it = gw; it < DEPTH * I_L; it += NGW) { const int l = it / I_L; int r = it % I_L;
            if (r < I_IN) transpose_item(a.w_in + (size_t)l * DM * DIN, DM, DIN, WinT + (size_t)l * DIN * DM, a.norm_g + l * DM, scr, r, lane);
            else transpose_item(a.w_out + (size_t)l * DM * DM, DM, DM, WoutT + (size_t)l * DM * DM, nullptr, scr, r - I_IN, lane); }
        for (int i = (bx * NTHREADS + tid); i < DEPTH * 4 * 128 * 128 / 2; i += G * NTHREADS) { const float2 v = ((const float2*)a.w_s)[i]; ((unsigned*)Wsb)[i] = pk2(v.x, v.y); }
        for (int i = (bx * NTHREADS + tid); i < 4 * M; i += G * NTHREADS) ssq[M + i] = 0ull;
        for (int i = (bx * NTHREADS + tid); i < DEPTH * NB * 32; i += G * NTHREADS) hmax[i] = 0u;
        for (int m0 = gw; m0 < M; m0 += 4 * NGW) {
            f32x4 v[4][4];
#pragma unroll
            for (int q = 0; q < 4; ++q) { const int m = m0 + q * NGW; if (m < M) { const float* xr = (m < M_P) ? a.xp + (size_t)m * DM : a.xs + (size_t)(m - M_P) * DM; const f32x4* x4 = (const f32x4*)xr + lane;
#pragma unroll
                for (int j = 0; j < 4; ++j) v[q][j] = x4[64 * j]; } }
#pragma unroll
            for (int q = 0; q < 4; ++q) { const int m = m0 + q * NGW; if (m < M) { float s = 0.f;
#pragma unroll
                for (int j = 0; j < 4; ++j) s += (v[q][j].x * v[q][j].x + v[q][j].y * v[q][j].y) + (v[q][j].z * v[q][j].z + v[q][j].w * v[q][j].w);
                s = wave_sum(s);
                if (lane == 0) ssq[m] = (unsigned long long)(s * pg8::SSQ_SCALE);
                unsigned long long* o8 = (unsigned long long*)(XB + (size_t)m * DM) + lane;
#pragma unroll
                for (int j = 0; j < 4; ++j) o8[64 * j] = (unsigned long long)pk2(v[q][j].x, v[q][j].y) | ((unsigned long long)pk2(v[q][j].z, v[q][j].w) << 32); } }
        }
        if (bx == 0 && wave == 0) {
            for (int l = 0; l < DEPTH; ++l) { const float* lq = a.lambda_qk + l * 256;
                const float s1 = wave_sum(lq[lane] * lq[64 + lane]), s2 = wave_sum(lq[128 + lane] * lq[192 + lane]);
                const float li = 0.8f - 0.6f * expf(-0.3f * (float)l);
                if (lane == 0) { misc[2 * l] = expf(s1) - expf(s2) + li; misc[2 * l + 1] = li; } }
        }
    }
    grid.sync();

    for (int l = 0; l < DEPTH; ++l) {
        {
            pg8::Gemm g{XB, WinT + (size_t)l * DIN * DM, M, DIN, DM, DM, 0}; pg8::StaticOrder S; S.init(M, DIN, G, bx);
            pg8::EpiZ E{Z, ssq + (size_t)l * M, 0.125f * 1.4426950408889634f, hmax + l * NB * 32};
#ifndef NO_GEMM1
            pg8::gemm_phase<pg8::EpiZ, pg8::StaticOrder, true, true>(lds, g, S, E, wave);
#endif
#ifdef PROBE_GEMM1X2
            grid.sync();
#ifdef PROBE_SYNC2
        grid.sync(); grid.sync(); grid.sync(); grid.sync();
#endif
            pg8::gemm_phase<pg8::EpiZ, pg8::StaticOrder, true, true>(lds, g, S, E, wave);
#endif
        }
        grid.sync();
#ifdef PROBE_SYNC2
        grid.sync(); grid.sync(); grid.sync(); grid.sync();
#endif
        {
            const float lam = __uint_as_float(__builtin_amdgcn_readfirstlane(__float_as_uint(misc[2 * l]))), li = __uint_as_float(__builtin_amdgcn_readfirstlane(__float_as_uint(misc[2 * l + 1])));
            const unsigned* hmaxL = hmax + l * NB * 32;
            const int nper = G / 8, xcd = vcu / nper, slot = vcu % nper;
#ifndef NO_ATT
            const int nunits = (G == 256) ? 12 : (NB * 4 * 32 - bx + G - 1) / G;
            for (int i = 0; i < nunits; ++i) { int pair, qb, pairN, qbN;
                if (G == 256) { pair = i * 8 + ((xcd + i) & 7); qb = (slot + 11 * i) & 31; pairN = (i + 1) * 8 + ((xcd + i + 1) & 7); qbN = (slot + 11 * (i + 1)) & 31; }
                else { const int u = bx + i * G; pair = u >> 5; qb = u & 31; pairN = (u + G) >> 5; qbN = (u + G) & 31; }
                const int b = pair >> 2, h = pair & 3;
                const float slope2 = exp2f(-2.0f * (float)(h + 1)) * 1.4426950408889634f;
                int W;
                { const unsigned* hp = hmaxL + b * 32 + h * 4; float R2 = 0.f;
                  for (int c = 0; c < 2; ++c) { const float q2 = __uint_as_float(__builtin_amdgcn_readfirstlane(hp[2 * c])) + __uint_as_float(__builtin_amdgcn_readfirstlane(hp[2 * c + 1]));
                      const float k2 = __uint_as_float(__builtin_amdgcn_readfirstlane(hp[16 + 2 * c])) + __uint_as_float(__builtin_amdgcn_readfirstlane(hp[16 + 2 * c + 1])); R2 = fmaxf(R2, q2 * k2); }
                  const float R = sqrtf(R2) * 1.02f + 0.5f; const float dd = (160.0f + 2.0f * R) / slope2;
                  const float wf = floorf((dd - 1.0f) * (1.0f / 64.0f)) + 1.0f; W = (wf >= 62.0f) ? 62 : (wf < 0.f ? 0 : (int)wf); }
                mix::attn_unit(lds, Z, b, h, qb, slope2, lam, 1.0f - li, a.subln_g + l * 128, wave, W, i == 0, i + 1 < nunits, pairN >> 2, pairN & 3, qbN); }
#endif
#ifndef NO_SGU
#ifdef PROBE_SGU2
            for (int u = bx; u < NB * 32; u += G)
                mix::sgu_unit(lds, Z, u >> 5, u & 31, a.vnorm_g + l * 512, Wsb + (size_t)l * 4 * 128 * 128, a.b_s + l * 512, wave, true);
#endif
            for (int u = bx; u < NB * 32; u += G)
                mix::sgu_unit(lds, Z, u >> 5, u & 31, a.vnorm_g + l * 512, Wsb + (size_t)l * 4 * 128 * 128, a.b_s + l * 512, wave);
#endif
        }
        grid.sync();
#ifdef PROBE_SYNC2
        grid.sync(); grid.sync(); grid.sync(); grid.sync();
#endif
        {
            pg8::Gemm g{Z, WoutT + (size_t)l * DM * DM, M, DM, DM, DIN, 3072}; pg8::StaticOrder S; S.init(M, DM, G, bx);
            pg8::EpiRes E{XB, ssq + (size_t)(l + 1) * M, false};
#ifdef PROBE_GEMM2X2
            { pg8::EpiRes E2 = E; E2.dry = true; pg8::gemm_phase<pg8::EpiRes, pg8::StaticOrder, true, true>(lds, g, S, E2, wave); grid.sync(); }
#endif
#ifndef NO_GEMM2
            pg8::gemm_phase<pg8::EpiRes, pg8::StaticOrder, true, true>(lds, g, S, E, wave);
#endif
        }
        grid.sync();
#ifdef PROBE_SYNC2
        grid.sync(); grid.sync(); grid.sync(); grid.sync();
#endif
    }
    {
        int lane_ = lane_now(); asm volatile("" : "+v"(lane_)); const int lane = lane_;
        const int gw = vcu * NWAVES + wave, NGW = G * NWAVES;
        const f32x4* g4 = (const f32x4*)a.final_g + lane; f32x4 gv[4];
#pragma unroll
        for (int j = 0; j < 4; ++j) gv[j] = g4[64 * j];
        for (int m0 = gw; m0 < M; m0 += 4 * NGW) {
            unsigned long long w[4][4]; unsigned long long sq[4];
#pragma unroll
            for (int q = 0; q < 4; ++q) { const int m = m0 + q * NGW; if (m < M) { sq[q] = ssq[(size_t)4 * M + m]; const unsigned long long* xr = (const unsigned long long*)(XB + (size_t)m * DM) + lane;
#pragma unroll
                for (int j = 0; j < 4; ++j) w[q][j] = xr[64 * j]; } }
#pragma unroll
            for (int q = 0; q < 4; ++q) { const int m = m0 + q * NGW; if (m < M) {
                const float rs = __builtin_amdgcn_rsqf((float)sq[q] * (pg8::SSQ_INV / 1024.0f) + 1e-6f);
                f32x4* o4 = (f32x4*)(a.out + (size_t)m * DM) + lane;
#pragma unroll
                for (int j = 0; j < 4; ++j) { const unsigned lo = (unsigned)w[q][j], hi = (unsigned)(w[q][j] >> 32);
                    f32x4 v = {__uint_as_float(lo << 16), __uint_as_float(lo & 0xffff0000u), __uint_as_float(hi << 16), __uint_as_float(hi & 0xffff0000u)};
                    o4[64 * j] = v * rs * gv[j]; } } }
        }
    }
}

extern "C" void kernel_launch(void* const* d_in, const int* in_sizes, int n_in, void* d_out, int out_size, void* d_ws, size_t ws_size, hipStream_t stream) {
    static int grid = 0;
    if (grid == 0) {
        if (n_in != 11 || in_sizes[0] != M_P * DM || out_size != M * DM || ws_size < WS_END) { fprintf(stderr, "kernel_launch: unexpected shapes (n_in %d in0 %d out %d ws %zu)\n", n_in, n_in > 0 ? in_sizes[0] : -1, out_size, ws_size); grid = -1; return; }
        int dev = 0, cus = 0, per_cu = 0;
        if (hipGetDevice(&dev) != hipSuccess || hipDeviceGetAttribute(&cus, hipDeviceAttributeMultiprocessorCount, dev) != hipSuccess) { grid = -1; return; }
        if (hipFuncSetAttribute((const void*)hymba_fwd, hipFuncAttributeMaxDynamicSharedMemorySize, LDS_BYTES) != hipSuccess) { fprintf(stderr, "kernel_launch: hipFuncSetAttribute failed\n"); grid = -1; return; }
        if (hipOccupancyMaxActiveBlocksPerMultiprocessor(&per_cu, (const void*)hymba_fwd, NTHREADS, LDS_BYTES) != hipSuccess || per_cu < 1) { fprintf(stderr, "kernel_launch: occupancy query says %d blocks per CU\n", per_cu); per_cu = 1; }
        (void)hipGetLastError();
        grid = cus;
    }
    if (grid < 0) return;
    Args a{};
    a.xp = (const float*)d_in[0]; a.xs = (const float*)d_in[1]; a.norm_g = (const float*)d_in[2]; a.w_in = (const float*)d_in[3]; a.lambda_qk = (const float*)d_in[4];
    a.subln_g = (const float*)d_in[5]; a.vnorm_g = (const float*)d_in[6]; a.w_s = (const float*)d_in[7]; a.b_s = (const float*)d_in[8]; a.w_out = (const float*)d_in[9]; a.final_g = (const float*)d_in[10];
    a.out = (float*)d_out; a.ws = (unsigned char*)d_ws;
    void* args[] = {&a};
    hipError_t e = hipLaunchCooperativeKernel((const void*)hymba_fwd, dim3(grid), dim3(NTHREADS), args, LDS_BYTES, stream);
    if (e != hipSuccess) fprintf(stderr, "kernel_launch: cooperative launch failed: %s (grid %d)\n", hipGetErrorString(e), grid);
}
```

```cpp
#include <hip/hip_runtime.h>
#include <hip/hip_bf16.h>
#include <hip/hip_cooperative_groups.h>
#include <cstdio>
#include <cstdint>
#include <cmath>
namespace cg = cooperative_groups;
__device__ __forceinline__ int lane_now() { unsigned z; asm volatile("s_mov_b32 %0, 0" : "=s"(z)); return (int)__builtin_amdgcn_mbcnt_hi(~0u, __builtin_amdgcn_mbcnt_lo(~0u, z)); }
namespace pg8 {
#define PG8_LAS __attribute__((address_space(3)))
typedef unsigned short bf16_t;
typedef short bf16x8 __attribute__((ext_vector_type(8)));
typedef float f32x4 __attribute__((ext_vector_type(4)));
typedef unsigned u32x4 __attribute__((ext_vector_type(4)));
constexpr int BM = 256, BK = 64, HALF = 128, HTB = HALF * BK * 2  , STAGE_BYTES = 8 * HTB, NXCD = 8, WGM = 8;

__host__ __device__ __forceinline__ int lds_byte(int r, int c) { const int st = (r >> 4) * 2 + (c >> 5), rr = r & 15, cc = c & 31, ob = rr * 64 + cc * 2; return st * 1024 + (ob ^ (((ob >> 9) & 1) << 5)); }
__host__ __device__ __forceinline__ void stage_rc(int b, int& R, int& C) { const int st = b / 1024, sb = b % 1024, swz = sb ^ (((sb >> 9) & 1) << 5); R = (st >> 1) * 16 + swz / 64; C = (st & 1) * 32 + (swz % 64) / 2; }
__host__ __device__ __forceinline__ int perm32(int rho) { const int n = rho >> 4, i = rho & 15; return 8 * (i >> 2) + 4 * n + (i & 3); }

struct Unit { int pm, pn; };
struct Gemm { const bf16_t* A; const bf16_t* Bt; int M, N, K, lda, kjump; };

struct StaticOrder {
    int nM, nN, nwg, G, c;
    __host__ __device__ void init(int M, int N, int G_, int c_) { nM = M / BM; nN = N / BM; nwg = nM * nN; G = G_; c = c_; }
    __host__ __device__ bool next(int i, Unit& u) const {
        const long L = (long)i * G + c; if (L >= nwg) return false;
        int wgid = (int)L; { const int q = nwg / NXCD, r = nwg % NXCD, xcd = wgid % NXCD, off = wgid / NXCD; wgid = (xcd < r ? xcd * (q + 1) : r * (q + 1) + (xcd - r) * q) + off; }
        const int nig = WGM * nN, gid = wgid / nig, fm = gid * WGM, gsz = (nM - fm) < WGM ? (nM - fm) : WGM;
        u.pm = fm + ((wgid % nig) % gsz); u.pn = (wgid % nig) / gsz; return true;
    }
    __device__ __forceinline__ void a_ready(const Unit&) const {}
    __device__ __forceinline__ void done(const Unit&) const {}
};

__device__ __forceinline__ unsigned cvt_pk_bf16(float lo, float hi) { unsigned r; asm volatile("v_cvt_pk_bf16_f32 %0, %1, %2" : "=v"(r) : "v"(lo), "v"(hi)); return r; }
constexpr int SSQ_SHIFT = 24;
constexpr float SSQ_SCALE = 16777216.0f, SSQ_INV = 1.0f / 16777216.0f;
struct EpiZ {
    static constexpr bool PERM = true, AFTER_DRAIN = false;
    bf16_t* Z; const unsigned long long* ssq; float c2; unsigned* hmax;
    __device__ __forceinline__ void operator()(const f32x4 (&acc)[2][2][4][2], const Unit& u, int wr, int wc, int fr, int fq) const {
        const int row0 = u.pm * BM + wr * 64 + fr; const int col0 = u.pn * BM + wc * 32 + 8 * fq;
        const float sc = (u.pn < 2) ? c2 : 1.0f;
        float hm0 = 0.f, hm1 = 0.f;
        unsigned long long sq[8];
#pragma unroll
        for (int i = 0; i < 8; ++i) sq[i] = ssq[row0 + (i >> 2) * HALF + (i & 3) * 16];
#pragma unroll
        for (int ai = 0; ai < 2; ++ai)
#pragma unroll
            for (int m = 0; m < 4; ++m) { const int row = row0 + ai * HALF + m * 16;
                const float ms = (float)sq[ai * 4 + m] * (SSQ_INV / 1024.0f);
                const float rs = __builtin_amdgcn_rsqf(ms + 1e-6f) * sc;
                bf16_t* rowp = Z + (size_t)row * 3584 + col0;
#pragma unroll
                for (int bj = 0; bj < 2; ++bj) { const f32x4 v0 = acc[ai][bj][m][0] * rs, v1 = acc[ai][bj][m][1] * rs;
                    u32x4 w; w.x = cvt_pk_bf16(v0[0], v0[1]); w.y = cvt_pk_bf16(v0[2], v0[3]); w.z = cvt_pk_bf16(v1[0], v1[1]); w.w = cvt_pk_bf16(v1[2], v1[3]);
                    *(u32x4*)(rowp + bj * HALF) = w;
                    if (u.pn < 4) { float q = (v0[0] * v0[0] + v0[1] * v0[1]) + (v0[2] * v0[2] + v0[3] * v0[3]) + (v1[0] * v1[0] + v1[1] * v1[1]) + (v1[2] * v1[2] + v1[3] * v1[3]);
                        q += __shfl_xor(q, 16); q += __shfl_xor(q, 32); if (bj == 0) hm0 = __builtin_fmaxf(hm0, q); else hm1 = __builtin_fmaxf(hm1, q); } } }
        if (u.pn < 4) {
#pragma unroll
            for (int o = 1; o < 16; o <<= 1) { hm0 = __builtin_fmaxf(hm0, __shfl_xor(hm0, o)); hm1 = __builtin_fmaxf(hm1, __shfl_xor(hm1, o)); }
            if (fr == 0 && fq == 0) { unsigned* hp = hmax + (u.pm >> 4) * 32 + u.pn * 8 + wc; atomicMax(hp, __float_as_uint(hm0)); atomicMax(hp + 4, __float_as_uint(hm1)); } }
    }
};
struct EpiRes {
    static constexpr bool PERM = true, AFTER_DRAIN = false;
    bf16_t* xb; unsigned long long* ssqn; bool dry;
    __device__ __forceinline__ void operator()(const f32x4 (&acc)[2][2][4][2], const Unit& u, int wr, int wc, int fr, int fq) const {
        const int row0 = u.pm * BM + wr * 64 + fr; const int col0 = u.pn * BM + wc * 32 + 8 * fq;
        u32x4 pre[2][4][2];
#pragma unroll
        for (int ai = 0; ai < 2; ++ai)
#pragma unroll
            for (int m = 0; m < 4; ++m)
#pragma unroll
                for (int bj = 0; bj < 2; ++bj) pre[ai][m][bj] = *(const u32x4*)(xb + (size_t)(row0 + ai * HALF + m * 16) * 1024 + col0 + bj * HALF);
#pragma unroll
        for (int ai = 0; ai < 2; ++ai)
#pragma unroll
            for (int m = 0; m < 4; ++m) { const int row = row0 + ai * HALF + m * 16; const size_t off = (size_t)row * 1024 + col0; float ss = 0.f;
#pragma unroll
                for (int bj = 0; bj < 2; ++bj) { const u32x4 bw = pre[ai][m][bj];
                    const f32x4 b0 = {__uint_as_float(bw.x << 16), __uint_as_float(bw.x & 0xffff0000u), __uint_as_float(bw.y << 16), __uint_as_float(bw.y & 0xffff0000u)};
                    const f32x4 b1 = {__uint_as_float(bw.z << 16), __uint_as_float(bw.z & 0xffff0000u), __uint_as_float(bw.w << 16), __uint_as_float(bw.w & 0xffff0000u)};
                    const f32x4 v0 = acc[ai][bj][m][0] + b0, v1 = acc[ai][bj][m][1] + b1;
                    u32x4 w; w.x = cvt_pk_bf16(v0[0], v0[1]); w.y = cvt_pk_bf16(v0[2], v0[3]); w.z = cvt_pk_bf16(v1[0], v1[1]); w.w = cvt_pk_bf16(v1[2], v1[3]);
                    if (!dry) *(u32x4*)(xb + off + bj * HALF) = w;
                    ss += (v0[0] * v0[0] + v0[1] * v0[1]) + (v0[2] * v0[2] + v0[3] * v0[3]) + (v1[0] * v1[0] + v1[1] * v1[1]) + (v1[2] * v1[2] + v1[3] * v1[3]); }
                ss += __shfl_xor(ss, 16); ss += __shfl_xor(ss, 32);
                if (fq == 0 && (!dry || ss < 0.f)) atomicAdd(ssqn + row, (unsigned long long)(ss * SSQ_SCALE)); }
    }
};
template <class Epi, class Sched, bool ALIGN_EPI = false, bool SP2 = false>
__device__ __forceinline__ void gemm_phase(PG8_LAS unsigned char* lds, const Gemm g, const Sched& S, const Epi& E, const int wave_in) {
    int tid_ = wave_in * 64 + lane_now(); asm volatile("" : "+v"(tid_));
    const int tid = tid_, wid = __builtin_amdgcn_readfirstlane(tid >> 6), lane = tid & 63, wr = wid >> 2, wc = wid & 3, fr = lane & 15, fq = lane >> 4;
    const int K = g.K, nt = K / BK;
    unsigned voffA[2], voffB[2];
#pragma unroll
    for (int i = 0; i < 2; ++i) { int R, C; stage_rc(tid * 16 + i * 8192, R, C); const int Rb = Epi::PERM ? ((R & ~31) + perm32(R & 31)) : R;
        voffA[i] = (unsigned)(R * g.lda + C) * 2u; voffB[i] = (unsigned)(Rb * K + C) * 2u; }
    const size_t kstep = (size_t)(BK * 2);
    const size_t hstepA = (size_t)HALF * g.lda * 2, hstepB = (size_t)HALF * K * 2;
    const size_t tstepA = 2 * hstepA, tstepB = 2 * hstepB;
    const size_t kjump = (size_t)g.kjump;
#define PG8_KOFFA(t) ((size_t)(t) * kstep + ((t) >= 8 ? kjump : (size_t)0))
    const unsigned ldsw = (unsigned)wid * 1024u;
    const int aoff = lds_byte(wr * 64 + fr, fq * 8), boff = lds_byte(wc * 32 + fr, fq * 8);
#define PG8_SA(b, h) (((b) * 2 + (h)) * HTB)
#define PG8_SB(b, h) ((4 + (b) * 2 + (h)) * HTB)
#define PG8_STAGE(bufoff, gbase, voff) do { _Pragma("unroll") for (int _i = 0; _i < 2; ++_i) \
        __builtin_amdgcn_global_load_lds((const unsigned*)((const char*)(gbase) + (voff)[_i]), (PG8_LAS unsigned*)(lds + (bufoff) + ldsw + _i * 8192), 16, 0, 0); } while (0)
#define PG8_LDA(dst, b, h) do { _Pragma("unroll") for (int m = 0; m < 4; ++m) _Pragma("unroll") for (int k = 0; k < 2; ++k) dst[m][k] = *(const PG8_LAS bf16x8*)(lds + PG8_SA(b, h) + aoff + m * 2048 + k * 1024); } while (0)
#define PG8_LDB(dst, b, h) do { _Pragma("unroll") for (int n = 0; n < 2; ++n) _Pragma("unroll") for (int k = 0; k < 2; ++k) dst[n][k] = *(const PG8_LAS bf16x8*)(lds + PG8_SB(b, h) + boff + n * 2048 + k * 1024); } while (0)
#define PG8_MMA(ai, bj, At, Bt) do { __builtin_amdgcn_s_setprio(1); _Pragma("unroll") for (int m = 0; m < 4; ++m) _Pragma("unroll") for (int n = 0; n < 2; ++n) _Pragma("unroll") for (int k = 0; k < 2; ++k) \
        acc[ai][bj][m][n] = __builtin_amdgcn_mfma_f32_16x16x32_bf16(Bt[n][k], At[m][k], acc[ai][bj][m][n], 0, 0, 0); __builtin_amdgcn_s_setprio(0); } while (0)
#define PG8_WAIT_V(n) asm volatile("s_waitcnt vmcnt(" #n ")" ::: "memory")
#define PG8_WAIT_L(n) asm volatile("s_waitcnt lgkmcnt(" #n ")" ::: "memory")
#define PG8_BAR __builtin_amdgcn_s_barrier()
#define PG8_SCHED __builtin_amdgcn_sched_barrier(0)
    Unit cur, nxt; int ui = 0;
    if (!S.next(0, cur)) return;
    f32x4 acc[2][2][4][2];
#pragma unroll
    for (int a = 0; a < 2; ++a)
#pragma unroll
        for (int b = 0; b < 2; ++b)
#pragma unroll
            for (int m = 0; m < 4; ++m)
#pragma unroll
                for (int n = 0; n < 2; ++n) acc[a][b][m][n] = (f32x4){0.f, 0.f, 0.f, 0.f};
    bf16x8 At[4][2], B0[2][2], B1[2][2];
    const char* cA = (const char*)g.A + (size_t)cur.pm * tstepA; const char* cB = (const char*)g.Bt + (size_t)cur.pn * tstepB;
    S.a_ready(cur);
    if constexpr (SP2) {
        PG8_STAGE(PG8_SB(0, 0), cB, voffB); PG8_STAGE(PG8_SB(0, 1), cB + hstepB, voffB); PG8_STAGE(PG8_SA(0, 0), cA, voffA); PG8_STAGE(PG8_SA(0, 1), cA + hstepA, voffA);
        if (wr == 1) PG8_BAR;
        PG8_WAIT_V(2); PG8_BAR;
        PG8_STAGE(PG8_SB(1, 0), cB + kstep, voffB); PG8_STAGE(PG8_SA(1, 0), cA + kstep, voffA); PG8_STAGE(PG8_SB(1, 1), cB + hstepB + kstep, voffB);
        PG8_WAIT_V(6); PG8_BAR;
    } else {
        PG8_STAGE(PG8_SB(0, 0), cB, voffB); PG8_STAGE(PG8_SA(0, 0), cA, voffA); PG8_STAGE(PG8_SB(0, 1), cB + hstepB, voffB); PG8_STAGE(PG8_SA(0, 1), cA + hstepA, voffA);
        if (wr == 1) PG8_BAR;
        PG8_WAIT_V(4); PG8_BAR;
        PG8_STAGE(PG8_SB(1, 0), cB + kstep, voffB); PG8_STAGE(PG8_SA(1, 0), cA + kstep, voffA); PG8_STAGE(PG8_SB(1, 1), cB + hstepB + kstep, voffB);
        PG8_WAIT_V(6); PG8_BAR;
    }
    for (;;) {
        const bool has_next = S.next(ui + 1, nxt);
        const char* nA = has_next ? (const char*)g.A + (size_t)nxt.pm * tstepA : cA; const char* nB = has_next ? (const char*)g.Bt + (size_t)nxt.pn * tstepB : cB;
        for (int t = 0; t < nt; t += 2) {
            const bool last = (t == nt - 2);
            const char* a1 = cA + PG8_KOFFA(t + 1);
            const char* a2 = last ? nA : cA + PG8_KOFFA(t + 2); const char* b2 = last ? nB : cB + (size_t)(t + 2) * kstep;
            const char* a3 = a2 + kstep; const char* b3 = b2 + kstep;
            if (last && has_next) S.a_ready(nxt);
            if constexpr (SP2) {
            PG8_LDB(B0, 0, 0); PG8_LDB(B1, 0, 1); PG8_SCHED; PG8_LDA(At, 0, 0); PG8_STAGE(PG8_SA(1, 1), a1 + hstepA, voffA);
            PG8_WAIT_V(8); PG8_WAIT_L(0); PG8_BAR; PG8_MMA(0, 0, At, B0); PG8_MMA(0, 1, At, B1); PG8_BAR; PG8_SCHED;
            PG8_LDA(At, 0, 1); PG8_STAGE(PG8_SB(0, 0), b2, voffB); PG8_STAGE(PG8_SB(0, 1), b2 + hstepB, voffB); PG8_STAGE(PG8_SA(0, 0), a2, voffA);
            PG8_WAIT_V(8); PG8_WAIT_L(0); PG8_BAR; PG8_MMA(1, 0, At, B0); PG8_MMA(1, 1, At, B1); PG8_BAR; PG8_SCHED;
            PG8_LDB(B0, 1, 0); PG8_LDB(B1, 1, 1); PG8_SCHED; PG8_LDA(At, 1, 0); PG8_STAGE(PG8_SA(0, 1), a2 + hstepA, voffA);
            PG8_WAIT_V(8); PG8_WAIT_L(0); PG8_BAR; PG8_MMA(0, 0, At, B0); PG8_MMA(0, 1, At, B1); PG8_BAR; PG8_SCHED;
            PG8_LDA(At, 1, 1); PG8_STAGE(PG8_SB(1, 0), b3, voffB); PG8_STAGE(PG8_SB(1, 1), b3 + hstepB, voffB); PG8_STAGE(PG8_SA(1, 0), a3, voffA);
            PG8_WAIT_V(8); PG8_WAIT_L(0); PG8_BAR; PG8_MMA(1, 0, At, B0); PG8_MMA(1, 1, At, B1); PG8_BAR; PG8_SCHED;
            } else {
            PG8_LDB(B0, 0, 0); PG8_SCHED; PG8_LDA(At, 0, 0); PG8_STAGE(PG8_SA(1, 1), a1 + hstepA, voffA);
            PG8_WAIT_L(8); PG8_BAR; PG8_WAIT_L(0); PG8_MMA(0, 0, At, B0); PG8_BAR; PG8_SCHED;
            PG8_LDB(B1, 0, 1); PG8_STAGE(PG8_SB(0, 0), b2, voffB);
            PG8_BAR; PG8_WAIT_L(0); PG8_MMA(0, 1, At, B1); PG8_BAR;
            PG8_LDA(At, 0, 1); PG8_STAGE(PG8_SA(0, 0), a2, voffA);
            PG8_BAR; PG8_WAIT_L(0); PG8_MMA(1, 0, At, B0); PG8_BAR; PG8_SCHED;
            PG8_STAGE(PG8_SB(0, 1), b2 + hstepB, voffB);
            PG8_WAIT_V(6); PG8_BAR; PG8_MMA(1, 1, At, B1); PG8_BAR;
            PG8_LDB(B0, 1, 0); PG8_SCHED; PG8_LDA(At, 1, 0); PG8_STAGE(PG8_SA(0, 1), a2 + hstepA, voffA);
            PG8_WAIT_L(8); PG8_BAR; PG8_WAIT_L(0); PG8_MMA(0, 0, At, B0); PG8_BAR; PG8_SCHED;
            PG8_LDB(B1, 1, 1); PG8_STAGE(PG8_SB(1, 0), b3, voffB);
            PG8_BAR; PG8_WAIT_L(0); PG8_MMA(0, 1, At, B1); PG8_BAR;
            PG8_LDA(At, 1, 1); PG8_STAGE(PG8_SA(1, 0), a3, voffA);
            PG8_BAR; PG8_WAIT_L(0); PG8_MMA(1, 0, At, B0); PG8_BAR; PG8_SCHED;
            PG8_STAGE(PG8_SB(1, 1), b3 + hstepB, voffB);
            PG8_WAIT_V(6); PG8_BAR; PG8_MMA(1, 1, At, B1); PG8_BAR;
            }
        }
        if constexpr (ALIGN_EPI) { if (wr == 0) PG8_BAR; }
        if constexpr (!Epi::AFTER_DRAIN) { E(acc, cur, wr, wc, fr, fq); S.done(cur); }
        if (!has_next) break;
#pragma unroll
        for (int a = 0; a < 2; ++a)
#pragma unroll
            for (int b = 0; b < 2; ++b)
#pragma unroll
                for (int m = 0; m < 4; ++m)
#pragma unroll
                    for (int n = 0; n < 2; ++n) acc[a][b][m][n] = (f32x4){0.f, 0.f, 0.f, 0.f};
        cur = nxt; cA = nA; cB = nB; ++ui;
        if constexpr (ALIGN_EPI) { if (wr == 1) PG8_BAR; }
    }
    PG8_WAIT_V(0);
    if constexpr (!ALIGN_EPI) { if (wr == 0) PG8_BAR; }
    PG8_BAR;
    if constexpr (Epi::AFTER_DRAIN) { E.fused(acc, cur, wr, wc, fr, fq, lds, wid, lane); S.done(cur); }
#undef PG8_KOFFA
#undef PG8_SA
#undef PG8_SB
#undef PG8_STAGE
#undef PG8_LDA
#undef PG8_LDB
#undef PG8_MMA
#undef PG8_WAIT_V
#undef PG8_WAIT_L
#undef PG8_BAR
#undef PG8_SCHED
}
}
namespace mix {
#define LAS __attribute__((address_space(3)))
typedef unsigned short bf16_t;
typedef short bf16x8 __attribute__((ext_vector_type(8)));
typedef short s16x4 __attribute__((ext_vector_type(4)));
typedef short v4i16_t __attribute__((ext_vector_type(4)));
typedef float f32x16 __attribute__((ext_vector_type(16)));
typedef float f32x4 __attribute__((ext_vector_type(4)));
typedef unsigned u32x4 __attribute__((ext_vector_type(4)));
typedef unsigned u32x2 __attribute__((ext_vector_type(2)));
typedef float f32x2_t __attribute__((ext_vector_type(2))); typedef __bf16 bf16x2_t __attribute__((ext_vector_type(2)));
constexpr int ZP = 3584, SEQ = 4096;
constexpr int KBUF = 32768;
constexpr int EXP = 132;
constexpr int QF_OFF = 98304;
constexpr int WSF_OFF = 131072;
constexpr float LOG2E = 1.4426950408889634f;
__device__ __forceinline__ int crow(int r, int hi) { return (r & 3) + 8 * (r >> 2) + 4 * hi; }
__device__ __forceinline__ unsigned cvtpk(float lo, float hi) { f32x2_t v = {lo, hi}; bf16x2_t b = __builtin_convertvector(v, bf16x2_t); return __builtin_bit_cast(unsigned, b); }
__device__ __forceinline__ float bf2f(unsigned short b) { return __uint_as_float((unsigned)b << 16); }
__device__ __forceinline__ float bflo(unsigned w) { return __uint_as_float(w << 16); }
__device__ __forceinline__ float bfhi(unsigned w) { return __uint_as_float(w & 0xffff0000u); }
__device__ __forceinline__ s16x4 vtr(const LAS unsigned char* p) { return __builtin_bit_cast(s16x4, __builtin_amdgcn_ds_read_tr16_b64_v4i16((LAS v4i16_t*)p)); }
__device__ __forceinline__ float swap32(float v) { auto rr = __builtin_amdgcn_permlane32_swap(__float_as_uint(v), __float_as_uint(v), false, false); return (__builtin_amdgcn_mbcnt_lo(~0u, 0u) & 32) ? __uint_as_float(rr[0]) : __uint_as_float(rr[1]); }
__device__ __forceinline__ float silu(float x) { return x * __builtin_amdgcn_rcpf(1.0f + __builtin_amdgcn_exp2f(-x * LOG2E)); }
__device__ __forceinline__ unsigned vtr_off(int lane, int cc, int t) {
    const int hi = lane >> 5, blk = (lane >> 4) & 1, q4 = (lane & 15) >> 2, p = lane & 3;
    return 256u * (4 * hi + 8 * t + q4) + 16u * (((cc ^ q4) << 2) | ((2 * blk + (p >> 1)) ^ (hi + 2 * t))) + 8u * (p & 1);
}
__device__ __forceinline__ void glds16(const void* gsrc, unsigned lds_dst) { unsigned keep;
    asm volatile("s_mov_b32 %0, m0\n\ts_mov_b32 m0, %2\n\ts_nop 0\n\tglobal_load_lds_dwordx4 %1, off\n\ts_mov_b32 m0, %0" : "=&s"(keep) : "v"(gsrc), "s"(lds_dst) : "memory"); }
__device__ __forceinline__ unsigned vst_off(int row, int ch) { return 256u * row + 16u * (ch ^ (((row & 3) << 2) | ((row >> 2) & 3))); }

__device__ __forceinline__ int att_tile(int i, int d0, int nl) { const int j = i - 2; const int tl = d0 - 1 - j, tr = d0 + i - nl; int t = (j < nl) ? tl : tr; t = (i < 2) ? d0 + i : t; return t; }
__device__ __forceinline__ void attn_unit(LAS unsigned char* lds, bf16_t* Z, int b, int h, int qb, float slope2, float lam, float oml, const float* subg, const int wave_in, const int W, const bool track, const bool first, const bool has_next, const int bN, const int hN, const int qbN, bool dry = false) {
    int tid_ = wave_in * 64 + lane_now(); asm volatile("" : "+v"(tid_));
    const int tid = tid_, lane = tid & 63, r32 = lane & 31, hi = lane >> 5; const int wid = __builtin_amdgcn_readfirstlane(tid >> 6);
    const int c = wid >> 2, qs = wid & 3;
    const size_t rowbase = (size_t)b * SEQ;
    LAS unsigned char* qlds = lds + QF_OFF + wid * 4096 + lane * 16;
    { const bf16_t* Qw = Z + (rowbase + qb * 128 + qs * 32 + r32) * ZP + h * 128 + c * 64 + hi * 8;
      bf16x8 qt[4];
#pragma unroll
      for (int s = 0; s < 4; ++s) qt[s] = *(const bf16x8*)(Qw + s * 16);
      asm volatile("" : "+v"(qt[0]), "+v"(qt[1]), "+v"(qt[2]), "+v"(qt[3]));
#pragma unroll
      for (int s = 0; s < 4; ++s) *(LAS bf16x8*)(qlds + s * 1024) = qt[s]; }
    const int vrow0 = 8 * wid + (lane >> 4), vrow1 = vrow0 + 4;
    const bf16_t* vg0 = Z + (rowbase + vrow0) * ZP + 1024 + h * 128 + ((lane & 15) ^ (((vrow0 & 3) << 2) | ((vrow0 >> 2) & 3))) * 8;
    const bf16_t* vg1 = Z + (rowbase + vrow1) * ZP + 1024 + h * 128 + ((lane & 15) ^ (((vrow1 & 3) << 2) | ((vrow1 >> 2) & 3))) * 8;
    const bf16_t* kg0 = vg0 - 512; const bf16_t* kg1 = vg1 - 512;
    unsigned kaddr[4], vaddr[4][2];
#pragma unroll
    for (int s = 0; s < 4; ++s) kaddr[s] = vst_off(r32, c * 8 + 2 * s + hi);
#pragma unroll
    for (int cc = 0; cc < 4; ++cc) { vaddr[cc][0] = 49152u + vtr_off(lane, cc, 0); vaddr[cc][1] = 49152u + vtr_off(lane, cc, 1); }
    LAS float* wsf = (LAS float*)(lds + WSF_OFF) + wid * 64;
    const unsigned lds0 = (unsigned)(uintptr_t)lds;
    const int q0w = qb * 128 + qs * 32, qpos = q0w + r32;
    bf16x8 kaug[2];
    { u32x4 w; w.y = hi ? 0x00003F80u : 0u; w.z = 0u; w.w = 0u;
      const unsigned k0b = __float_as_uint((float)r32) >> 16, k1b = __float_as_uint((float)(32 + r32)) >> 16;
      w.x = hi ? 0x3F803F80u : (k0b | (k0b << 16)); kaug[0] = __builtin_bit_cast(bf16x8, w);
      w.x = hi ? 0x3F803F80u : (k1b | (k1b << 16)); kaug[1] = __builtin_bit_cast(bf16x8, w); }
    unsigned slw;
    { const unsigned sh = cvtpk(slope2, 0.f) & 0xffffu; const float shf = __uint_as_float(sh << 16); const unsigned sl = cvtpk(slope2 - shf, 0.f) & 0xffffu; slw = sh | (sl << 16); }
    bf16x8 ones; { u32x4 w; w.x = w.y = w.z = w.w = 0x3F803F80u; ones = __builtin_bit_cast(bf16x8, w); }
    f32x16 ol = f32x16{};
    const int d0 = 2 * qb;
    float mhat = 0.f; f32x16 o[4]; const f32x16 zero16 = f32x16{};
#pragma unroll
    for (int cc = 0; cc < 4; ++cc) o[cc] = f32x16{};
    const int nl = (d0 < W) ? d0 : W, nr = (62 - d0 < W) ? 62 - d0 : W, NT = 2 + nl + nr;
#define ATT_TILE(i) att_tile((i), d0, nl)
#define ATT_DMAK_(k0p, k1p, tile, slot) do { const size_t go = (size_t)(tile) * 64 * ZP; const unsigned bb = lds0 + (slot) * 16384 + wid * 2048; \
        glds16((k0p) + go, (unsigned)__builtin_amdgcn_readfirstlane(bb)); glds16((k1p) + go, (unsigned)__builtin_amdgcn_readfirstlane(bb + 1024)); } while (0)
#define ATT_DMAK(tile, slot) ATT_DMAK_(kg0, kg1, tile, slot)
#define ATT_DMAV_(v0p, v1p, tile, slot) do { const size_t go = (size_t)(tile) * 64 * ZP; const unsigned bb = lds0 + 49152 + (slot) * 16384 + wid * 2048; \
        glds16((v0p) + go, (unsigned)__builtin_amdgcn_readfirstlane(bb)); glds16((v1p) + go, (unsigned)__builtin_amdgcn_readfirstlane(bb + 1024)); } while (0)
#define ATT_DMAV(tile, slot) ATT_DMAV_(vg0, vg1, tile, slot)
#define ATT_BAR() do { asm volatile("s_waitcnt vmcnt(0)" ::: "memory"); __syncthreads(); } while (0)
#define ATT_BAR4() do { asm volatile("s_waitcnt vmcnt(4)" ::: "memory"); __syncthreads(); } while (0)
#define MX3(a, b, c) __builtin_fmaxf(__builtin_fmaxf((a), (b)), (c))
#define ATT_QAUG(dst, kvs) do { const float sg_ = ((kvs) <= q0w) ? 1.0f : -1.0f; const float x_ = __builtin_fmaf(sg_ * slope2, (float)((tile_) * 64 - qpos), -mhat); \
        const unsigned wa_ = cvtpk(x_, x_); const float r1_ = x_ - __uint_as_float(wa_ & 0xffff0000u); const unsigned wb_ = cvtpk(r1_, r1_); const float r2_ = r1_ - __uint_as_float(wb_ & 0xffff0000u); \
        const unsigned wc_ = cvtpk(r2_, 0.f); u32x4 w_; w_.x = hi ? ((wa_ & 0xffffu) | (wb_ & 0xffff0000u)) : (((kvs) <= q0w) ? slw : (slw ^ 0x80008000u)); w_.y = hi ? wc_ : 0u; w_.z = 0u; w_.w = 0u; dst = __builtin_bit_cast(bf16x8, w_); } while (0)
#define ATT_QK(tile, kslot) do { const int tile_ = (tile); const LAS unsigned char* kb_ = lds + (kslot) * 16384; bf16x8 kf_[8]; \
        _Pragma("unroll") for (int s = 0; s < 4; ++s) { kf_[2 * s] = *(const LAS bf16x8*)(kb_ + kaddr[s]); kf_[2 * s + 1] = *(const LAS bf16x8*)(kb_ + kaddr[s] + 8192); } \
        bf16x8 qf[4]; _Pragma("unroll") for (int s = 0; s < 4; ++s) qf[s] = *(const LAS bf16x8*)(qlds + s * 1024); \
        bf16x8 qa0_, qa1_; ATT_QAUG(qa0_, tile_ * 64); ATT_QAUG(qa1_, tile_ * 64 + 32); \
        s0 = __builtin_amdgcn_mfma_f32_32x32x16_bf16(kaug[0], qa0_, zero16, 0, 0, 0); s1 = __builtin_amdgcn_mfma_f32_32x32x16_bf16(kaug[1], qa1_, zero16, 0, 0, 0); \
        _Pragma("unroll") for (int s = 0; s < 4; ++s) { s0 = __builtin_amdgcn_mfma_f32_32x32x16_bf16(kf_[2 * s], qf[s], s0, 0, 0, 0); s1 = __builtin_amdgcn_mfma_f32_32x32x16_bf16(kf_[2 * s + 1], qf[s], s1, 0, 0, 0); } \
        if (tile_ == d0 + (qs >> 1)) { const float m2_ = -2.0f * slope2; \
            if (qs & 1) { _Pragma("unroll") for (int r = 0; r < 16; ++r) s1[r] = __builtin_fmaf(m2_, __builtin_fmaxf((float)(crow(r, hi) - r32), 0.f), s1[r]); } \
            else { _Pragma("unroll") for (int r = 0; r < 16; ++r) s0[r] = __builtin_fmaf(m2_, __builtin_fmaxf((float)(crow(r, hi) - r32), 0.f), s0[r]); } } } while (0)
#define ATT_QK_OFF(tile, kslot) do { const int tile_ = (tile); const LAS unsigned char* kb_ = lds + (kslot) * 16384; bf16x8 kf_[8]; \
        _Pragma("unroll") for (int s = 0; s < 4; ++s) { kf_[2 * s] = *(const LAS bf16x8*)(kb_ + kaddr[s]); kf_[2 * s + 1] = *(const LAS bf16x8*)(kb_ + kaddr[s] + 8192); } \
        bf16x8 qf[4]; _Pragma("unroll") for (int s = 0; s < 4; ++s) qf[s] = *(const LAS bf16x8*)(qlds + s * 1024); \
        bf16x8 qa0_; ATT_QAUG(qa0_, tile_ * 64); \
        s0 = __builtin_amdgcn_mfma_f32_32x32x16_bf16(kaug[0], qa0_, zero16, 0, 0, 0); s1 = __builtin_amdgcn_mfma_f32_32x32x16_bf16(kaug[1], qa0_, zero16, 0, 0, 0); \
        _Pragma("unroll") for (int s = 0; s < 4; ++s) { s0 = __builtin_amdgcn_mfma_f32_32x32x16_bf16(kf_[2 * s], qf[s], s0, 0, 0, 0); s1 = __builtin_amdgcn_mfma_f32_32x32x16_bf16(kf_[2 * s + 1], qf[s], s1, 0, 0, 0); } } while (0)
#define ATT_ROWMAX(rm) do { float a_ = MX3(s0[0], s0[1], s1[0]), b_ = MX3(s0[2], s0[3], s1[1]); a_ = MX3(a_, s1[2], s1[3]); \
        _Pragma("unroll") for (int r = 4; r < 16; r += 4) { a_ = MX3(a_, s0[r], s0[r + 1]); b_ = MX3(b_, s0[r + 2], s0[r + 3]); a_ = MX3(a_, s1[r], s1[r + 1]); b_ = MX3(b_, s1[r + 2], s1[r + 3]); } \
        rm = __builtin_fmaxf(a_, b_); rm = __builtin_fmaxf(rm, swap32(rm)); } while (0)
#define ATT_RESC_CHECK(rm) do { if (__any(rm > 8.0f)) { const float dl = __builtin_fmaxf(rm, 0.f); mhat += dl; \
        _Pragma("unroll") for (int r = 0; r < 16; ++r) { s0[r] -= dl; s1[r] -= dl; } \
        const float f = __builtin_amdgcn_exp2f(-dl); wsf[r32] = f; resc = true; } } while (0)
#define ATT_EXP_PACK() do { \
        _Pragma("unroll") for (int r = 0; r < 16; ++r) { s0[r] = __builtin_amdgcn_exp2f(s0[r]); s1[r] = __builtin_amdgcn_exp2f(s1[r]); } \
        u32x4 w; \
        w.x = cvtpk(s0[0], s0[1]); w.y = cvtpk(s0[2], s0[3]); w.z = cvtpk(s0[4], s0[5]); w.w = cvtpk(s0[6], s0[7]); pf[0] = __builtin_bit_cast(bf16x8, w); \
        w.x = cvtpk(s0[8], s0[9]); w.y = cvtpk(s0[10], s0[11]); w.z = cvtpk(s0[12], s0[13]); w.w = cvtpk(s0[14], s0[15]); pf[1] = __builtin_bit_cast(bf16x8, w); \
        w.x = cvtpk(s1[0], s1[1]); w.y = cvtpk(s1[2], s1[3]); w.z = cvtpk(s1[4], s1[5]); w.w = cvtpk(s1[6], s1[7]); pf[2] = __builtin_bit_cast(bf16x8, w); \
        w.x = cvtpk(s1[8], s1[9]); w.y = cvtpk(s1[10], s1[11]); w.z = cvtpk(s1[12], s1[13]); w.w = cvtpk(s1[14], s1[15]); pf[3] = __builtin_bit_cast(bf16x8, w); } while (0)
#define ATT_RESC_APPLY() do { if (resc) { asm volatile("s_waitcnt lgkmcnt(0)" ::: "memory"); __builtin_amdgcn_wave_barrier(); \
        _Pragma("unroll") for (int k = 0; k < 4; ++k) { const f32x4 fv_ = *(const LAS f32x4*)(wsf + 8 * k + 4 * hi); \
            _Pragma("unroll") for (int cc = 0; cc < 4; ++cc) { o[cc][4 * k + 0] *= fv_[0]; o[cc][4 * k + 1] *= fv_[1]; o[cc][4 * k + 2] *= fv_[2]; o[cc][4 * k + 3] *= fv_[3]; } \
            ol[4 * k + 0] *= fv_[0]; ol[4 * k + 1] *= fv_[1]; ol[4 * k + 2] *= fv_[2]; ol[4 * k + 3] *= fv_[3]; } \
        asm volatile("s_waitcnt lgkmcnt(0)" ::: "memory"); __builtin_amdgcn_wave_barrier(); } } while (0)
#define ATT_VRD(dst, vb_, cc) do { _Pragma("unroll") for (int ks = 0; ks < 4; ++ks) { dst[2 * ks] = vtr(vb_ + vaddr[cc][0] + ks * 4096); dst[2 * ks + 1] = vtr(vb_ + vaddr[cc][1] + ks * 4096); } } while (0)
#define ATT_VF(src, ks) (bf16x8){src[2 * (ks)][0], src[2 * (ks)][1], src[2 * (ks)][2], src[2 * (ks)][3], src[2 * (ks) + 1][0], src[2 * (ks) + 1][1], src[2 * (ks) + 1][2], src[2 * (ks) + 1][3]}
#define ATT_PV(cc, src) do { _Pragma("unroll") for (int ks = 0; ks < 4; ++ks) o[cc] = __builtin_amdgcn_mfma_f32_32x32x16_bf16(pf[ks], ATT_VF(src, ks), o[cc], 0, 0, 0); } while (0)
    f32x16 s0, s1; bf16x8 pf[4]; bool resc = false;
    if (c == 0) __builtin_amdgcn_s_setprio(1);
    {
        if (first) { ATT_DMAK(ATT_TILE(0), 0); ATT_DMAV(ATT_TILE(0), 0); ATT_DMAK(ATT_TILE(1), 1); }
        { const int i2 = (2 < NT) ? 2 : NT - 1; const int t2 = ATT_TILE(i2); ATT_DMAK(t2, 2); ATT_DMAV(ATT_TILE(1), 1); } }
    ATT_BAR4();
    { ATT_QK(ATT_TILE(0), 0); if (track) { float rm; ATT_ROWMAX(rm); ATT_RESC_CHECK(rm); } ATT_EXP_PACK(); resc = false; }
    ATT_BAR();
#define ATT_PVC(cc, src) do { _Pragma("unroll") for (int ks = 0; ks < 4; ++ks) o[cc] = __builtin_amdgcn_mfma_f32_32x32x16_bf16(pc[ks], ATT_VF(src, ks), o[cc], 0, 0, 0); } while (0)
#define ATT_LSUM() do { _Pragma("unroll") for (int ks = 0; ks < 4; ++ks) ol = __builtin_amdgcn_mfma_f32_32x32x16_bf16(pc[ks], ones, ol, 0, 0, 0); } while (0)
    int m3 = 0;
    {
        const int i = 0;
        const int m3p1 = (m3 == 2) ? 0 : m3 + 1, m3p2 = (m3 == 0) ? 2 : m3 - 1;
        { const int i3 = __builtin_elementwise_min(i + 3, NT - 1); const int t3 = ATT_TILE(i3); ATT_DMAK(t3, m3); }
        { const int i2 = __builtin_elementwise_min(i + 2, NT - 1); const int t2 = ATT_TILE(i2); ATT_DMAV(t2, m3p2); }
        const int t1 = ATT_TILE(i + 1);
        const LAS unsigned char* vb = lds + m3 * 16384;
        s16x4 va[8], vbb[8];
        bf16x8 pc[4];
#pragma unroll
        for (int k = 0; k < 4; ++k) pc[k] = pf[k];
        ATT_VRD(va, vb, 0);
        ATT_QK(t1, m3p1);
        ATT_VRD(vbb, vb, 1);
        if (track) { float rm; ATT_ROWMAX(rm); ATT_RESC_CHECK(rm); }
        ATT_PVC(0, va);
        ATT_VRD(va, vb, 2);
        ATT_PVC(1, vbb);
        ATT_VRD(vbb, vb, 3);
        ATT_EXP_PACK();
        ATT_PVC(2, va);
        ATT_LSUM();
        ATT_PVC(3, vbb);
        asm volatile("" : "+v"(pf[0]), "+v"(pf[1]), "+v"(pf[2]), "+v"(pf[3]));
#pragma unroll
        for (int g_ = 0; g_ < 16; ++g_) { __builtin_amdgcn_sched_group_barrier(0x008, 1, 0); __builtin_amdgcn_sched_group_barrier(0x002, 3, 0); __builtin_amdgcn_sched_group_barrier(0x100, 1, 0); }
        __builtin_amdgcn_sched_group_barrier(0x008, 4, 0);
        ATT_RESC_APPLY(); resc = false;
        ATT_BAR4();
        m3 = m3p1;
    }
    for (int i = 1; i < NT - 1; ++i) {
        const int m3p1 = (m3 == 2) ? 0 : m3 + 1, m3p2 = (m3 == 0) ? 2 : m3 - 1;
        { const int i3 = __builtin_elementwise_min(i + 3, NT - 1); const int t3 = ATT_TILE(i3); ATT_DMAK(t3, m3); }
        { const int i2 = __builtin_elementwise_min(i + 2, NT - 1); const int t2 = ATT_TILE(i2); ATT_DMAV(t2, m3p2); }
        const int t1 = ATT_TILE(i + 1);
        const LAS unsigned char* vb = lds + m3 * 16384;
        s16x4 va[8], vbb[8];
        bf16x8 pc[4];
#pragma unroll
        for (int k = 0; k < 4; ++k) pc[k] = pf[k];
        ATT_VRD(va, vb, 0);
        ATT_QK_OFF(t1, m3p1);
        ATT_VRD(vbb, vb, 1);
        if (track) { float rm; ATT_ROWMAX(rm); ATT_RESC_CHECK(rm); }
        ATT_PVC(0, va);
        ATT_VRD(va, vb, 2);
        ATT_PVC(1, vbb);
        ATT_VRD(vbb, vb, 3);
        ATT_EXP_PACK();
        ATT_PVC(2, va);
        ATT_LSUM();
        ATT_PVC(3, vbb);
        asm volatile("" : "+v"(pf[0]), "+v"(pf[1]), "+v"(pf[2]), "+v"(pf[3]));
#pragma unroll
        for (int g_ = 0; g_ < 16; ++g_) { __builtin_amdgcn_sched_group_barrier(0x008, 1, 0); __builtin_amdgcn_sched_group_barrier(0x002, 3, 0); __builtin_amdgcn_sched_group_barrier(0x100, 1, 0); }
        __builtin_amdgcn_sched_group_barrier(0x008, 4, 0);
        ATT_RESC_APPLY(); resc = false;
        ATT_BAR4();
        m3 = m3p1;
    }
    {
        const LAS unsigned char* vb = lds + m3 * 16384;
        s16x4 va[8], vbb[8]; bf16x8 pc[4];
#pragma unroll
        for (int k = 0; k < 4; ++k) pc[k] = pf[k];
        ATT_VRD(va, vb, 0); ATT_VRD(vbb, vb, 1); ATT_PVC(0, va); ATT_VRD(va, vb, 2); ATT_PVC(1, vbb); ATT_VRD(vbb, vb, 3); ATT_PVC(2, va); ATT_LSUM(); ATT_PVC(3, vbb);
        ATT_BAR();
    }
    __builtin_amdgcn_s_setprio(0);
    if (has_next) {
        const size_t rbN = (size_t)bN * SEQ; const int d0N = 2 * qbN;
        const bf16_t* vgN0 = Z + (rbN + vrow0) * ZP + 1024 + hN * 128 + ((lane & 15) ^ (((vrow0 & 3) << 2) | ((vrow0 >> 2) & 3))) * 8;
        const bf16_t* vgN1 = Z + (rbN + vrow1) * ZP + 1024 + hN * 128 + ((lane & 15) ^ (((vrow1 & 3) << 2) | ((vrow1 >> 2) & 3))) * 8;
        ATT_DMAK_(vgN0 - 512, vgN1 - 512, d0N, 0); ATT_DMAV_(vgN0, vgN1, d0N, 0); ATT_DMAK_(vgN0 - 512, vgN1 - 512, d0N + 1, 1);
    }
#undef ATT_TILE
#undef ATT_DMAK
#undef ATT_DMAK_
#undef ATT_DMAV_
#undef ATT_BAR
#undef ATT_BAR4
#undef ATT_DMAV
#undef ATT_QK
#undef ATT_QK_OFF
#undef ATT_ROWMAX
#undef ATT_RESC_CHECK
#undef ATT_EXP_PACK
#undef ATT_RESC_APPLY
#undef ATT_VRD
#undef ATT_VF
#undef ATT_PV
#undef ATT_PVC
#undef ATT_LSUM
#undef ATT_QAUG
#undef MX3
    u32x2 gpre[8];
#pragma unroll
    for (int it = 0; it < 8; ++it) gpre[it] = *(const u32x2*)(Z + (rowbase + qb * 128 + wid * 16 + 2 * it + hi) * ZP + h * 128 + 4 * r32 + 1536);
    f32x4 fv[4];
    { const float lc = (c == 0) ? 1.0f : -lam;
#pragma unroll
      for (int k = 0; k < 4; ++k) { fv[k][0] = lc * __builtin_amdgcn_rcpf(ol[4 * k + 0]); fv[k][1] = lc * __builtin_amdgcn_rcpf(ol[4 * k + 1]); fv[k][2] = lc * __builtin_amdgcn_rcpf(ol[4 * k + 2]); fv[k][3] = lc * __builtin_amdgcn_rcpf(ol[4 * k + 3]); } }
    LAS float* Ex = (LAS float*)(lds + 65536);
    if (c == 1) {
#pragma unroll
        for (int cc = 0; cc < 4; ++cc)
#pragma unroll
            for (int r = 0; r < 16; ++r) Ex[(qs * 32 + crow(r, hi)) * EXP + cc * 32 + r32] = o[cc][r] * fv[r >> 2][r & 3];
    }
    __syncthreads();
    if (c == 0) {
#pragma unroll
        for (int cc = 0; cc < 4; ++cc)
#pragma unroll
            for (int r = 0; r < 16; ++r) { LAS float* p = Ex + (qs * 32 + crow(r, hi)) * EXP + cc * 32 + r32; *p = *p + o[cc][r] * fv[r >> 2][r & 3]; }
    }
    __syncthreads();
    { const f32x4 sg = *(const f32x4*)(subg + 4 * r32);
#pragma unroll
      for (int it = 0; it < 8; ++it) { const int row = wid * 16 + 2 * it + hi;
        const f32x4 v = *(const LAS f32x4*)(Ex + row * EXP + 4 * r32);
        float ss = (v[0] * v[0] + v[1] * v[1]) + (v[2] * v[2] + v[3] * v[3]);
        ss += __shfl_xor(ss, 1); ss += __shfl_xor(ss, 2); ss += __shfl_xor(ss, 4); ss += __shfl_xor(ss, 8); ss += __shfl_xor(ss, 16);
        const float rs = __builtin_amdgcn_rsqf(ss * (1.0f / 128.0f) + 1e-6f) * oml;
        bf16_t* zr = Z + (rowbase + qb * 128 + row) * ZP + h * 128 + 4 * r32;
        const u32x2 gw = gpre[it];
        const float o0 = v[0] * rs * sg[0] * silu(bflo(gw.x)), o1 = v[1] * rs * sg[1] * silu(bfhi(gw.x)), o2 = v[2] * rs * sg[2] * silu(bflo(gw.y)), o3 = v[3] * rs * sg[3] * silu(bfhi(gw.y));
        u32x2 ow; ow.x = cvtpk(o0, o1); ow.y = cvtpk(o2, o3); if (!dry) *(u32x2*)zr = ow; } }
    __syncthreads();
}

__device__ __forceinline__ void sgu_unit(LAS unsigned char* lds, bf16_t* Z, int b, int chunk, const float* vng, const bf16_t* Wsb, const float* bs, const int wave_in, bool dry = false) {
    int tid_ = wave_in * 64 + lane_now(); asm volatile("" : "+v"(tid_));
    const int tid = tid_, lane = tid & 63, r32 = lane & 31, hi = lane >> 5; const int wid = __builtin_amdgcn_readfirstlane(tid >> 6);
    const size_t rowbase = (size_t)b * SEQ + (size_t)chunk * 128;
    { f32x4 g0 = *(const f32x4*)(vng + lane * 8), g1 = *(const f32x4*)(vng + lane * 8 + 4);
#pragma unroll 8
      for (int it = 0; it < 16; ++it) { const int row = wid * 16 + it;
        const u32x4 raw = *(const u32x4*)(Z + (rowbase + row) * ZP + 2560 + lane * 8);
        float x[8] = {bflo(raw.x), bfhi(raw.x), bflo(raw.y), bfhi(raw.y), bflo(raw.z), bfhi(raw.z), bflo(raw.w), bfhi(raw.w)};
        float ss = 0.f;
#pragma unroll
        for (int j = 0; j < 8; ++j) ss += x[j] * x[j];
#pragma unroll
        for (int of = 1; of < 64; of <<= 1) ss += __shfl_xor(ss, of);
        const float rs = __builtin_amdgcn_rsqf(ss * (1.0f / 512.0f) + 1e-6f);
        u32x4 w; w.x = cvtpk(x[0] * rs * g0[0], x[1] * rs * g0[1]); w.y = cvtpk(x[2] * rs * g0[2], x[3] * rs * g0[3]); w.z = cvtpk(x[4] * rs * g1[0], x[5] * rs * g1[1]); w.w = cvtpk(x[6] * rs * g1[2], x[7] * rs * g1[3]);
        *(LAS u32x4*)(lds + (lane >> 4) * 32768 + vst_off(row, lane & 15)) = w; } }
    __syncthreads();
    const int tb = wid & 3, dh = wid >> 2;
    unsigned va[2][2];
#pragma unroll
    for (int c2 = 0; c2 < 2; ++c2) { va[c2][0] = vtr_off(lane, dh * 2 + c2, 0); va[c2][1] = vtr_off(lane, dh * 2 + c2, 1); }
    for (int g = 0; g < 4; ++g) {
        bf16x8 af[8];
        { const bf16_t* wp = Wsb + ((size_t)(g * 128 + tb * 32 + r32)) * 128 + 4 * hi;
#pragma unroll
          for (int ks = 0; ks < 8; ++ks) { const u32x2 lo = *(const u32x2*)(wp + 16 * ks), hh = *(const u32x2*)(wp + 16 * ks + 8); u32x4 w; w.x = lo.x; w.y = lo.y; w.z = hh.x; w.w = hh.y; af[ks] = __builtin_bit_cast(bf16x8, w); } }
        f32x16 acc[2]; acc[0] = f32x16{}; acc[1] = f32x16{};
        const LAS unsigned char* tbp = lds + g * 32768;
#pragma unroll
        for (int c2 = 0; c2 < 2; ++c2)
#pragma unroll
            for (int ks = 0; ks < 8; ++ks) { const s16x4 lo = vtr(tbp + va[c2][0] + ks * 4096), hh = vtr(tbp + va[c2][1] + ks * 4096);
                const bf16x8 vf = (bf16x8){lo[0], lo[1], lo[2], lo[3], hh[0], hh[1], hh[2], hh[3]};
                acc[c2] = __builtin_amdgcn_mfma_f32_32x32x16_bf16(af[ks], vf, acc[c2], 0, 0, 0); }
        unsigned short uu_[2][16], gg_[2][16];
#pragma unroll
        for (int c2 = 0; c2 < 2; ++c2)
#pragma unroll
            for (int r = 0; r < 16; ++r) { const int t = tb * 32 + crow(r, hi); const int col = g * 128 + (dh * 2 + c2) * 32 + r32;
                const bf16_t* zp = Z + (rowbase + t) * ZP + 2048 + col; uu_[c2][r] = zp[0]; gg_[c2][r] = zp[1024]; }
#pragma unroll
        for (int c2 = 0; c2 < 2; ++c2)
#pragma unroll
            for (int r = 0; r < 16; ++r) { const int t = tb * 32 + crow(r, hi); const int col = g * 128 + (dh * 2 + c2) * 32 + r32;
                bf16_t* zp = Z + (rowbase + t) * ZP + 2048 + col;
                const float sv = acc[c2][r] + bs[g * 128 + t];
                const float ov = bf2f(uu_[c2][r]) * sv * silu(bf2f(gg_[c2][r]));
                if (!dry) zp[0] = (bf16_t)(cvtpk(ov, 0.f) & 0xffffu); }
    }
    __syncthreads();
}
#undef LAS
}
#define LAS __attribute__((address_space(3)))
typedef unsigned short bf16;
typedef unsigned v4u __attribute__((ext_vector_type(4)));
typedef float f32x4 __attribute__((ext_vector_type(4)));
constexpr int NWAVES = 8, NTHREADS = 512;
constexpr int DM = 1024, DIN = 3584, DEPTH = 4, SEQ = 4096, NB_P = 8, NB_S = 16, NB = 24;
constexpr int M = NB * SEQ;
constexpr int M_P = NB_P * SEQ;
constexpr size_t MiB = 1u << 20;
constexpr size_t WS_MISC = 0;
constexpr size_t WS_HMAX = 65536;
constexpr size_t WS_WIN = 1 * MiB;
constexpr size_t WS_WOUT = 30 * MiB;
constexpr size_t WS_WS = 39 * MiB;
constexpr size_t WS_SSQ = 40 * MiB;
constexpr size_t WS_XB = 44 * MiB;
constexpr size_t WS_Z = 240 * MiB;
constexpr size_t WS_END = WS_Z + (size_t)M * DIN * 2;
static_assert(WS_XB + (size_t)M * DM * 2 <= WS_Z && WS_END <= (size_t)1024 * MiB, "d_ws map");
constexpr int LDS_BYTES = 139264;

__device__ __forceinline__ unsigned f2bf(float f) { unsigned u = __builtin_bit_cast(unsigned, f); return (u + 0x7fffu + ((u >> 16) & 1u)) >> 16; }
__device__ __forceinline__ unsigned pk2(float lo, float hi) { return f2bf(lo) | (f2bf(hi) << 16); }
__device__ __forceinline__ float wave_sum(float v) {
#pragma unroll
    for (int o = 1; o < 64; o <<= 1) v += __shfl_xor(v, o);
    return v;
}
__device__ __forceinline__ void transpose_item(const float* W, int K, int N, bf16* WT, const float* gsc, LAS float* scr, int item, int lane) {
    const int nblk = N / 32, kb = item / nblk, nb = item % nblk, k0 = 64 * kb, n0 = 32 * nb;
#pragma unroll 8
    for (int i = 0; i < 32; ++i) { const int kk = 2 * i + (lane >> 5); const float sc = gsc ? gsc[k0 + kk] : 1.0f; scr[kk * 33 + (lane & 31)] = W[(size_t)(k0 + kk) * N + n0 + (lane & 31)] * sc; }
    asm volatile("s_waitcnt lgkmcnt(0)" ::: "memory");
    const int c = lane & 7;
#pragma unroll
    for (int j = 0; j < 4; ++j) { const int n = (lane >> 3) + 8 * j; const LAS float* s = scr + (8 * c) * 33 + n;
        v4u o; o.x = pk2(s[0 * 33], s[1 * 33]); o.y = pk2(s[2 * 33], s[3 * 33]); o.z = pk2(s[4 * 33], s[5 * 33]); o.w = pk2(s[6 * 33], s[7 * 33]);
        *(v4u*)(WT + (size_t)(n0 + n) * K + k0 + 8 * c) = o; }
    asm volatile("s_waitcnt lgkmcnt(0)" ::: "memory");
}

struct Args { const float* xp; const float* xs; const float* norm_g; const float* w_in; const float* lambda_qk; const float* subln_g; const float* vnorm_g;
              const float* w_s; const float* b_s; const float* w_out; const float* final_g; float* out; unsigned char* ws; };

__global__ void __launch_bounds__(NTHREADS) hymba_fwd(Args a) {
    extern __shared__ __attribute__((aligned(16))) unsigned char lds_raw[];
    LAS unsigned char* lds = (LAS unsigned char*)lds_raw;
    cg::grid_group grid = cg::this_grid();
    const int tid = threadIdx.x, lane = tid & 63; const int wave = __builtin_amdgcn_readfirstlane(tid >> 6);
    const int G = gridDim.x, bx = blockIdx.x;
    const int vcu = (G % 8 == 0) ? (bx % 8) * (G / 8) + bx / 8 : bx;
    unsigned char* ws = a.ws;
    float* misc = (float*)(ws + WS_MISC);
    unsigned* hmax = (unsigned*)(ws + WS_HMAX);
    bf16* WinT = (bf16*)(ws + WS_WIN); bf16* WoutT = (bf16*)(ws + WS_WOUT); bf16* Wsb = (bf16*)(ws + WS_WS);
    unsigned long long* ssq = (unsigned long long*)(ws + WS_SSQ);
    bf16* XB = (bf16*)(ws + WS_XB); bf16* Z = (bf16*)(ws + WS_Z);

    {
        const int gw = vcu * NWAVES + wave, NGW = G * NWAVES;
        LAS float* scr = (LAS float*)(lds + wave * 16384);
        constexpr int I_IN = (DM / 64) * (DIN / 32), I_OUT = (DM / 64) * (DM / 32), I_L = I_IN + I_OUT;
        for (int it = gw; it < DEPTH * I_L; it += NGW) { const int l = it / I_L; int r = it % I_L;
            if (r < I_IN) transpose_item(a.w_in + (size_t)l * DM * DIN, DM, DIN, WinT + (size_t)l * DIN * DM, a.norm_g + l * DM, scr, r, lane);
            else transpose_item(a.w_out + (size_t)l * DM * DM, DM, DM, WoutT + (size_t)l * DM * DM, nullptr, scr, r - I_IN, lane); }
        for (int i = (bx * NTHREADS + tid); i < DEPTH * 4 * 128 * 128 / 2; i += G * NTHREADS) { const float2 v = ((const float2*)a.w_s)[i]; ((unsigned*)Wsb)[i] = pk2(v.x, v.y); }
        for (int i = (bx * NTHREADS + tid); i < 4 * M; i += G * NTHREADS) ssq[M + i] = 0ull;
        for (int i = (bx * NTHREADS + tid); i < DEPTH * NB * 32; i += G * NTHREADS) hmax[i] = 0u;
        for (int m0 = gw; m0 < M; m0 += 4 * NGW) {
            f32x4 v[4][4];
#pragma unroll
            for (int q = 0; q < 4; ++q) { const int m = m0 + q * NGW; if (m < M) { const float* xr = (m < M_P) ? a.xp + (size_t)m * DM : a.xs + (size_t)(m - M_P) * DM; const f32x4* x4 = (const f32x4*)xr + lane;
#pragma unroll
                for (int j = 0; j < 4; ++j) v[q][j] = x4[64 * j]; } }
#pragma unroll
            for (int q = 0; q < 4; ++q) { const int m = m0 + q * NGW; if (m < M) { float s = 0.f;
#pragma unroll
                for (int j = 0; j < 4; ++j) s += (v[q][j].x * v[q][j].x + v[q][j].y * v[q][j].y) + (v[q][j].z * v[q][j].z + v[q][j].w * v[q][j].w);
                s = wave_sum(s);
                if (lane == 0) ssq[m] = (unsigned long long)(s * pg8::SSQ_SCALE);
                unsigned long long* o8 = (unsigned long long*)(XB + (size_t)m * DM) + lane;
#pragma unroll
                for (int j = 0; j < 4; ++j) o8[64 * j] = (unsigned long long)pk2(v[q][j].x, v[q][j].y) | ((unsigned long long)pk2(v[q][j].z, v[q][j].w) << 32); } }
        }
        if (bx == 0 && wave == 0) {
            for (int l = 0; l < DEPTH; ++l) { const float* lq = a.lambda_qk + l * 256;
                const float s1 = wave_sum(lq[lane] * lq[64 + lane]), s2 = wave_sum(lq[128 + lane] * lq[192 + lane]);
                const float li = 0.8f - 0.6f * expf(-0.3f * (float)l);
                if (lane == 0) { misc[2 * l] = expf(s1) - expf(s2) + li; misc[2 * l + 1] = li; } }
        }
    }
    grid.sync();

    for (int l = 0; l < DEPTH; ++l) {
        {
            pg8::Gemm g{XB, WinT + (size_t)l * DIN * DM, M, DIN, DM, DM, 0}; pg8::StaticOrder S; S.init(M, DIN, G, bx);
            pg8::EpiZ E{Z, ssq + (size_t)l * M, 0.125f * 1.4426950408889634f, hmax + l * NB * 32};
#ifndef NO_GEMM1
            pg8::gemm_phase<pg8::EpiZ, pg8::StaticOrder, true, true>(lds, g, S, E, wave);
#endif
#ifdef PROBE_GEMM1X2
            grid.sync();
#ifdef PROBE_SYNC2
        grid.sync(); grid.sync(); grid.sync(); grid.sync();
#endif
            pg8::gemm_phase<pg8::EpiZ, pg8::StaticOrder, true, true>(lds, g, S, E, wave);
#endif
        }
        grid.sync();
#ifdef PROBE_SYNC2
        grid.sync(); grid.sync(); grid.sync(); grid.sync();
#endif
        {
            const float lam = __uint_as_float(__builtin_amdgcn_readfirstlane(__float_as_uint(misc[2 * l]))), li = __uint_as_float(__builtin_amdgcn_readfirstlane(__float_as_uint(misc[2 * l + 1])));
            const unsigned* hmaxL = hmax + l * NB * 32;
            const int nper = G / 8, xcd = vcu / nper, slot = vcu % nper;
#ifndef NO_ATT
            const int nunits = (G == 256) ? 12 : (NB * 4 * 32 - bx + G - 1) / G;
            for (int i = 0; i < nunits; ++i) { int pair, qb, pairN, qbN;
                if (G == 256) { pair = i * 8 + ((xcd + i) & 7); qb = (slot + 11 * i) & 31; pairN = (i + 1) * 8 + ((xcd + i + 1) & 7); qbN = (slot + 11 * (i + 1)) & 31; }
                else { const int u = bx + i * G; pair = u >> 5; qb = u & 31; pairN = (u + G) >> 5; qbN = (u + G) & 31; }
                const int b = pair >> 2, h = pair & 3;
                const float slope2 = exp2f(-2.0f * (float)(h + 1)) * 1.4426950408889634f;
                int W; float Rg;
                { const unsigned* hp = hmaxL + b * 32 + h * 4; float R2 = 0.f;
                  for (int c = 0; c < 2; ++c) { const float q2 = __uint_as_float(__builtin_amdgcn_readfirstlane(hp[2 * c])) + __uint_as_float(__builtin_amdgcn_readfirstlane(hp[2 * c + 1]));
                      const float k2 = __uint_as_float(__builtin_amdgcn_readfirstlane(hp[16 + 2 * c])) + __uint_as_float(__builtin_amdgcn_readfirstlane(hp[16 + 2 * c + 1])); R2 = fmaxf(R2, q2 * k2); }
                  const float R = sqrtf(R2) * 1.02f + 0.5f; Rg = R; const float dd = (160.0f + 2.0f * R) / slope2;
                  const float wf = floorf((dd - 1.0f) * (1.0f / 64.0f)) + 1.0f; W = (wf >= 62.0f) ? 62 : (wf < 0.f ? 0 : (int)wf); }
                const bool track = !(Rg <= 48.0f);
                mix::attn_unit(lds, Z, b, h, qb, slope2, lam, 1.0f - li, a.subln_g + l * 128, wave, W, track, i == 0, i + 1 < nunits, pairN >> 2, pairN & 3, qbN); }
#endif
#ifndef NO_SGU
#ifdef PROBE_SGU2
            for (int u = bx; u < NB * 32; u += G)
                mix::sgu_unit(lds, Z, u >> 5, u & 31, a.vnorm_g + l * 512, Wsb + (size_t)l * 4 * 128 * 128, a.b_s + l * 512, wave, true);
#endif
            for (int u = bx; u < NB * 32; u += G)
                mix::sgu_unit(lds, Z, u >> 5, u & 31, a.vnorm_g + l * 512, Wsb + (size_t)l * 4 * 128 * 128, a.b_s + l * 512, wave);
#endif
        }
        grid.sync();
#ifdef PROBE_SYNC2
        grid.sync(); grid.sync(); grid.sync(); grid.sync();
#endif
        {
            pg8::Gemm g{Z, WoutT + (size_t)l * DM * DM, M, DM, DM, DIN, 3072}; pg8::StaticOrder S; S.init(M, DM, G, bx);
            pg8::EpiRes E{XB, ssq + (size_t)(l + 1) * M, false};
#ifdef PROBE_GEMM2X2
            { pg8::EpiRes E2 = E; E2.dry = true; pg8::gemm_phase<pg8::EpiRes, pg8::StaticOrder, true, true>(lds, g, S, E2, wave); grid.sync(); }
#endif
#ifndef NO_GEMM2
            pg8::gemm_phase<pg8::EpiRes, pg8::StaticOrder, true, true>(lds, g, S, E, wave);
#endif
        }
        grid.sync();
#ifdef PROBE_SYNC2
        grid.sync(); grid.sync(); grid.sync(); grid.sync();
#endif
    }
    {
        int lane_ = lane_now(); asm volatile("" : "+v"(lane_)); const int lane = lane_;
        const int gw = vcu * NWAVES + wave, NGW = G * NWAVES;
        const f32x4* g4 = (const f32x4*)a.final_g + lane; f32x4 gv[4];
#pragma unroll
        for (int j = 0; j < 4; ++j) gv[j] = g4[64 * j];
        for (int m0 = gw; m0 < M; m0 += 4 * NGW) {
            unsigned long long w[4][4]; unsigned long long sq[4];
#pragma unroll
            for (int q = 0; q < 4; ++q) { const int m = m0 + q * NGW; if (m < M) { sq[q] = ssq[(size_t)4 * M + m]; const unsigned long long* xr = (const unsigned long long*)(XB + (size_t)m * DM) + lane;
#pragma unroll
                for (int j = 0; j < 4; ++j) w[q][j] = xr[64 * j]; } }
#pragma unroll
            for (int q = 0; q < 4; ++q) { const int m = m0 + q * NGW; if (m < M) {
                const float rs = __builtin_amdgcn_rsqf((float)sq[q] * (pg8::SSQ_INV / 1024.0f) + 1e-6f);
                f32x4* o4 = (f32x4*)(a.out + (size_t)m * DM) + lane;
#pragma unroll
                for (int j = 0; j < 4; ++j) { const unsigned lo = (unsigned)w[q][j], hi = (unsigned)(w[q][j] >> 32);
                    f32x4 v = {__uint_as_float(lo << 16), __uint_as_float(lo & 0xffff0000u), __uint_as_float(hi << 16), __uint_as_float(hi & 0xffff0000u)};
                    o4[64 * j] = v * rs * gv[j]; } } }
        }
    }
}

extern "C" void kernel_launch(void* const* d_in, const int* in_sizes, int n_in, void* d_out, int out_size, void* d_ws, size_t ws_size, hipStream_t stream) {
    static int grid = 0;
    if (grid == 0) {
        if (n_in != 11 || in_sizes[0] != M_P * DM || out_size != M * DM || ws_size < WS_END) { fprintf(stderr, "kernel_launch: unexpected shapes (n_in %d in0 %d out %d ws %zu)\n", n_in, n_in > 0 ? in_sizes[0] : -1, out_size, ws_size); grid = -1; return; }
        int dev = 0, cus = 0, per_cu = 0;
        if (hipGetDevice(&dev) != hipSuccess || hipDeviceGetAttribute(&cus, hipDeviceAttributeMultiprocessorCount, dev) != hipSuccess) { grid = -1; return; }
        if (hipFuncSetAttribute((const void*)hymba_fwd, hipFuncAttributeMaxDynamicSharedMemorySize, LDS_BYTES) != hipSuccess) { fprintf(stderr, "kernel_launch: hipFuncSetAttribute failed\n"); grid = -1; return; }
        if (hipOccupancyMaxActiveBlocksPerMultiprocessor(&per_cu, (const void*)hymba_fwd, NTHREADS, LDS_BYTES) != hipSuccess || per_cu < 1) { fprintf(stderr, "kernel_launch: occupancy query says %d blocks per CU\n", per_cu); per_cu = 1; }
        (void)hipGetLastError();
        grid = cus;
    }
    if (grid < 0) return;
    Args a{};
    a.xp = (const float*)d_in[0]; a.xs = (const float*)d_in[1]; a.norm_g = (const float*)d_in[2]; a.w_in = (const float*)d_in[3]; a.lambda_qk = (const float*)d_in[4];
    a.subln_g = (const float*)d_in[5]; a.vnorm_g = (const float*)d_in[6]; a.w_s = (const float*)d_in[7]; a.b_s = (const float*)d_in[8]; a.w_out = (const float*)d_in[9]; a.final_g = (const float*)d_in[10];
    a.out = (float*)d_out; a.ws = (unsigned char*)d_ws;
    void* args[] = {&a};
    hipError_t e = hipLaunchCooperativeKernel((const void*)hymba_fwd, dim3(grid), dim3(NTHREADS), args, LDS_BYTES, stream);
    if (e != hipSuccess) fprintf(stderr, "kernel_launch: cooperative launch failed: %s (grid %d)\n", hipGetErrorString(e), grid);
}
```

```cpp
#include <hip/hip_runtime.h>
#include <hip/hip_bf16.h>
#include <hip/hip_cooperative_groups.h>
#include <cstdio>
#include <cstdint>
#include <cmath>
namespace cg = cooperative_groups;
__device__ __forceinline__ int lane_now() { unsigned z; asm volatile("s_mov_b32 %0, 0" : "=s"(z)); return (int)__builtin_amdgcn_mbcnt_hi(~0u, __builtin_amdgcn_mbcnt_lo(~0u, z)); }
namespace pg8 {
#define PG8_LAS __attribute__((address_space(3)))
typedef unsigned short bf16_t;
typedef short bf16x8 __attribute__((ext_vector_type(8)));
typedef float f32x4 __attribute__((ext_vector_type(4)));
typedef unsigned u32x4 __attribute__((ext_vector_type(4)));
constexpr int BM = 256, BK = 64, HALF = 128, HTB = HALF * BK * 2  , STAGE_BYTES = 8 * HTB, NXCD = 8, WGM = 8;

__host__ __device__ __forceinline__ int lds_byte(int r, int c) { const int st = (r >> 4) * 2 + (c >> 5), rr = r & 15, cc = c & 31, ob = rr * 64 + cc * 2; return st * 1024 + (ob ^ (((ob >> 9) & 1) << 5)); }
__host__ __device__ __forceinline__ void stage_rc(int b, int& R, int& C) { const int st = b / 1024, sb = b % 1024, swz = sb ^ (((sb >> 9) & 1) << 5); R = (st >> 1) * 16 + swz / 64; C = (st & 1) * 32 + (swz % 64) / 2; }
__host__ __device__ __forceinline__ int perm32(int rho) { const int n = rho >> 4, i = rho & 15; return 8 * (i >> 2) + 4 * n + (i & 3); }

struct Unit { int pm, pn; };
struct Gemm { const bf16_t* A; const bf16_t* Bt; int M, N, K, lda, kjump; };

struct StaticOrder {
    int nM, nN, nwg, G, c;
    __host__ __device__ void init(int M, int N, int G_, int c_) { nM = M / BM; nN = N / BM; nwg = nM * nN; G = G_; c = c_; }
    __host__ __device__ bool next(int i, Unit& u) const {
        const long L = (long)i * G + c; if (L >= nwg) return false;
        int wgid = (int)L; { const int q = nwg / NXCD, r = nwg % NXCD, xcd = wgid % NXCD, off = wgid / NXCD; wgid = (xcd < r ? xcd * (q + 1) : r * (q + 1) + (xcd - r) * q) + off; }
        const int nig = WGM * nN, gid = wgid / nig, fm = gid * WGM, gsz = (nM - fm) < WGM ? (nM - fm) : WGM;
        u.pm = fm + ((wgid % nig) % gsz); u.pn = (wgid % nig) / gsz; return true;
    }
    __device__ __forceinline__ void a_ready(const Unit&) const {}
    __device__ __forceinline__ void done(const Unit&) const {}
};

__device__ __forceinline__ unsigned cvt_pk_bf16(float lo, float hi) { unsigned r; asm volatile("v_cvt_pk_bf16_f32 %0, %1, %2" : "=v"(r) : "v"(lo), "v"(hi)); return r; }
constexpr int SSQ_SHIFT = 24;
constexpr float SSQ_SCALE = 16777216.0f, SSQ_INV = 1.0f / 16777216.0f;
struct EpiZ {
    static constexpr bool PERM = true, AFTER_DRAIN = false;
    bf16_t* Z; const unsigned long long* ssq; float c2; unsigned* hmax;
    __device__ __forceinline__ void operator()(const f32x4 (&acc)[2][2][4][2], const Unit& u, int wr, int wc, int fr, int fq) const {
        const int row0 = u.pm * BM + wr * 64 + fr; const int col0 = u.pn * BM + wc * 32 + 8 * fq;
        const float sc = (u.pn < 2) ? c2 : 1.0f;
        float hm0 = 0.f, hm1 = 0.f;
        unsigned long long sq[8];
#pragma unroll
        for (int i = 0; i < 8; ++i) sq[i] = ssq[row0 + (i >> 2) * HALF + (i & 3) * 16];
#pragma unroll
        for (int ai = 0; ai < 2; ++ai)
#pragma unroll
            for (int m = 0; m < 4; ++m) { const int row = row0 + ai * HALF + m * 16;
                const float ms = (float)sq[ai * 4 + m] * (SSQ_INV / 1024.0f);
                const float rs = __builtin_amdgcn_rsqf(ms + 1e-6f) * sc;
                bf16_t* rowp = Z + (size_t)row * 3584 + col0;
#pragma unroll
                for (int bj = 0; bj < 2; ++bj) { const f32x4 v0 = acc[ai][bj][m][0] * rs, v1 = acc[ai][bj][m][1] * rs;
                    u32x4 w; w.x = cvt_pk_bf16(v0[0], v0[1]); w.y = cvt_pk_bf16(v0[2], v0[3]); w.z = cvt_pk_bf16(v1[0], v1[1]); w.w = cvt_pk_bf16(v1[2], v1[3]);
                    *(u32x4*)(rowp + bj * HALF) = w;
                    if (u.pn < 4) { float q = (v0[0] * v0[0] + v0[1] * v0[1]) + (v0[2] * v0[2] + v0[3] * v0[3]) + (v1[0] * v1[0] + v1[1] * v1[1]) + (v1[2] * v1[2] + v1[3] * v1[3]);
                        q += __shfl_xor(q, 16); q += __shfl_xor(q, 32); if (bj == 0) hm0 = __builtin_fmaxf(hm0, q); else hm1 = __builtin_fmaxf(hm1, q); } } }
        if (u.pn < 4) {
#pragma unroll
            for (int o = 1; o < 16; o <<= 1) { hm0 = __builtin_fmaxf(hm0, __shfl_xor(hm0, o)); hm1 = __builtin_fmaxf(hm1, __shfl_xor(hm1, o)); }
            if (fr == 0 && fq == 0) { unsigned* hp = hmax + (u.pm >> 4) * 32 + u.pn * 8 + wc; atomicMax(hp, __float_as_uint(hm0)); atomicMax(hp + 4, __float_as_uint(hm1)); } }
    }
};
struct EpiRes {
    static constexpr bool PERM = true, AFTER_DRAIN = false;
    bf16_t* xb; unsigned long long* ssqn; bool dry;
    __device__ __forceinline__ void operator()(const f32x4 (&acc)[2][2][4][2], const Unit& u, int wr, int wc, int fr, int fq) const {
        const int row0 = u.pm * BM + wr * 64 + fr; const int col0 = u.pn * BM + wc * 32 + 8 * fq;
        u32x4 pre[2][4][2];
#pragma unroll
        for (int ai = 0; ai < 2; ++ai)
#pragma unroll
            for (int m = 0; m < 4; ++m)
#pragma unroll
                for (int bj = 0; bj < 2; ++bj) pre[ai][m][bj] = *(const u32x4*)(xb + (size_t)(row0 + ai * HALF + m * 16) * 1024 + col0 + bj * HALF);
#pragma unroll
        for (int ai = 0; ai < 2; ++ai)
#pragma unroll
            for (int m = 0; m < 4; ++m) { const int row = row0 + ai * HALF + m * 16; const size_t off = (size_t)row * 1024 + col0; float ss = 0.f;
#pragma unroll
                for (int bj = 0; bj < 2; ++bj) { const u32x4 bw = pre[ai][m][bj];
                    const f32x4 b0 = {__uint_as_float(bw.x << 16), __uint_as_float(bw.x & 0xffff0000u), __uint_as_float(bw.y << 16), __uint_as_float(bw.y & 0xffff0000u)};
                    const f32x4 b1 = {__uint_as_float(bw.z << 16), __uint_as_float(bw.z & 0xffff0000u), __uint_as_float(bw.w << 16), __uint_as_float(bw.w & 0xffff0000u)};
                    const f32x4 v0 = acc[ai][bj][m][0] + b0, v1 = acc[ai][bj][m][1] + b1;
                    u32x4 w; w.x = cvt_pk_bf16(v0[0], v0[1]); w.y = cvt_pk_bf16(v0[2], v0[3]); w.z = cvt_pk_bf16(v1[0], v1[1]); w.w = cvt_pk_bf16(v1[2], v1[3]);
                    if (!dry) *(u32x4*)(xb + off + bj * HALF) = w;
                    ss += (v0[0] * v0[0] + v0[1] * v0[1]) + (v0[2] * v0[2] + v0[3] * v0[3]) + (v1[0] * v1[0] + v1[1] * v1[1]) + (v1[2] * v1[2] + v1[3] * v1[3]); }
                ss += __shfl_xor(ss, 16); ss += __shfl_xor(ss, 32);
                if (fq == 0 && (!dry || ss < 0.f)) atomicAdd(ssqn + row, (unsigned long long)(ss * SSQ_SCALE)); }
    }
};
template <class Epi, class Sched, bool ALIGN_EPI = false, bool SP2 = false>
__device__ __forceinline__ void gemm_phase(PG8_LAS unsigned char* lds, const Gemm g, const Sched& S, const Epi& E, const int wave_in) {
    int tid_ = wave_in * 64 + lane_now(); asm volatile("" : "+v"(tid_));
    const int tid = tid_, wid = __builtin_amdgcn_readfirstlane(tid >> 6), lane = tid & 63, wr = wid >> 2, wc = wid & 3, fr = lane & 15, fq = lane >> 4;
    const int K = g.K, nt = K / BK;
    unsigned voffA[2], voffB[2];
#pragma unroll
    for (int i = 0; i < 2; ++i) { int R, C; stage_rc(tid * 16 + i * 8192, R, C); const int Rb = Epi::PERM ? ((R & ~31) + perm32(R & 31)) : R;
        voffA[i] = (unsigned)(R * g.lda + C) * 2u; voffB[i] = (unsigned)(Rb * K + C) * 2u; }
    const size_t kstep = (size_t)(BK * 2);
    const size_t hstepA = (size_t)HALF * g.lda * 2, hstepB = (size_t)HALF * K * 2;
    const size_t tstepA = 2 * hstepA, tstepB = 2 * hstepB;
    const size_t kjump = (size_t)g.kjump;
#define PG8_KOFFA(t) ((size_t)(t) * kstep + ((t) >= 8 ? kjump : (size_t)0))
    const unsigned ldsw = (unsigned)wid * 1024u;
    const int aoff = lds_byte(wr * 64 + fr, fq * 8), boff = lds_byte(wc * 32 + fr, fq * 8);
#define PG8_SA(b, h) (((b) * 2 + (h)) * HTB)
#define PG8_SB(b, h) ((4 + (b) * 2 + (h)) * HTB)
#define PG8_STAGE(bufoff, gbase, voff) do { _Pragma("unroll") for (int _i = 0; _i < 2; ++_i) \
        __builtin_amdgcn_global_load_lds((const unsigned*)((const char*)(gbase) + (voff)[_i]), (PG8_LAS unsigned*)(lds + (bufoff) + ldsw + _i * 8192), 16, 0, 0); } while (0)
#define PG8_LDA(dst, b, h) do { _Pragma("unroll") for (int m = 0; m < 4; ++m) _Pragma("unroll") for (int k = 0; k < 2; ++k) dst[m][k] = *(const PG8_LAS bf16x8*)(lds + PG8_SA(b, h) + aoff + m * 2048 + k * 1024); } while (0)
#define PG8_LDB(dst, b, h) do { _Pragma("unroll") for (int n = 0; n < 2; ++n) _Pragma("unroll") for (int k = 0; k < 2; ++k) dst[n][k] = *(const PG8_LAS bf16x8*)(lds + PG8_SB(b, h) + boff + n * 2048 + k * 1024); } while (0)
#define PG8_MMA(ai, bj, At, Bt) do { __builtin_amdgcn_s_setprio(1); _Pragma("unroll") for (int m = 0; m < 4; ++m) _Pragma("unroll") for (int n = 0; n < 2; ++n) _Pragma("unroll") for (int k = 0; k < 2; ++k) \
        acc[ai][bj][m][n] = __builtin_amdgcn_mfma_f32_16x16x32_bf16(Bt[n][k], At[m][k], acc[ai][bj][m][n], 0, 0, 0); __builtin_amdgcn_s_setprio(0); } while (0)
#define PG8_WAIT_V(n) asm volatile("s_waitcnt vmcnt(" #n ")" ::: "memory")
#define PG8_WAIT_L(n) asm volatile("s_waitcnt lgkmcnt(" #n ")" ::: "memory")
#define PG8_BAR __builtin_amdgcn_s_barrier()
#define PG8_SCHED __builtin_amdgcn_sched_barrier(0)
    Unit cur, nxt; int ui = 0;
    if (!S.next(0, cur)) return;
    f32x4 acc[2][2][4][2];
#pragma unroll
    for (int a = 0; a < 2; ++a)
#pragma unroll
        for (int b = 0; b < 2; ++b)
#pragma unroll
            for (int m = 0; m < 4; ++m)
#pragma unroll
                for (int n = 0; n < 2; ++n) acc[a][b][m][n] = (f32x4){0.f, 0.f, 0.f, 0.f};
    bf16x8 At[4][2], B0[2][2], B1[2][2];
    const char* cA = (const char*)g.A + (size_t)cur.pm * tstepA; const char* cB = (const char*)g.Bt + (size_t)cur.pn * tstepB;
    S.a_ready(cur);
    if constexpr (SP2) {
        PG8_STAGE(PG8_SB(0, 0), cB, voffB); PG8_STAGE(PG8_SB(0, 1), cB + hstepB, voffB); PG8_STAGE(PG8_SA(0, 0), cA, voffA); PG8_STAGE(PG8_SA(0, 1), cA + hstepA, voffA);
        if (wr == 1) PG8_BAR;
        PG8_WAIT_V(2); PG8_BAR;
        PG8_STAGE(PG8_SB(1, 0), cB + kstep, voffB); PG8_STAGE(PG8_SA(1, 0), cA + kstep, voffA); PG8_STAGE(PG8_SB(1, 1), cB + hstepB + kstep, voffB);
        PG8_WAIT_V(6); PG8_BAR;
    } else {
        PG8_STAGE(PG8_SB(0, 0), cB, voffB); PG8_STAGE(PG8_SA(0, 0), cA, voffA); PG8_STAGE(PG8_SB(0, 1), cB + hstepB, voffB); PG8_STAGE(PG8_SA(0, 1), cA + hstepA, voffA);
        if (wr == 1) PG8_BAR;
        PG8_WAIT_V(4); PG8_BAR;
        PG8_STAGE(PG8_SB(1, 0), cB + kstep, voffB); PG8_STAGE(PG8_SA(1, 0), cA + kstep, voffA); PG8_STAGE(PG8_SB(1, 1), cB + hstepB + kstep, voffB);
        PG8_WAIT_V(6); PG8_BAR;
    }
    for (;;) {
        const bool has_next = S.next(ui + 1, nxt);
        const char* nA = has_next ? (const char*)g.A + (size_t)nxt.pm * tstepA : cA; const char* nB = has_next ? (const char*)g.Bt + (size_t)nxt.pn * tstepB : cB;
        for (int t = 0; t < nt; t += 2) {
            const bool last = (t == nt - 2);
            const char* a1 = cA + PG8_KOFFA(t + 1);
            const char* a2 = last ? nA : cA + PG8_KOFFA(t + 2); const char* b2 = last ? nB : cB + (size_t)(t + 2) * kstep;
            const char* a3 = a2 + kstep; const char* b3 = b2 + kstep;
            if (last && has_next) S.a_ready(nxt);
            if constexpr (SP2) {
            PG8_LDB(B0, 0, 0); PG8_LDB(B1, 0, 1); PG8_SCHED; PG8_LDA(At, 0, 0); PG8_STAGE(PG8_SA(1, 1), a1 + hstepA, voffA);
            PG8_WAIT_V(8); PG8_WAIT_L(0); PG8_BAR; PG8_MMA(0, 0, At, B0); PG8_MMA(0, 1, At, B1); PG8_BAR; PG8_SCHED;
            PG8_LDA(At, 0, 1); PG8_STAGE(PG8_SB(0, 0), b2, voffB); PG8_STAGE(PG8_SB(0, 1), b2 + hstepB, voffB); PG8_STAGE(PG8_SA(0, 0), a2, voffA);
            PG8_WAIT_V(8); PG8_WAIT_L(0); PG8_BAR; PG8_MMA(1, 0, At, B0); PG8_MMA(1, 1, At, B1); PG8_BAR; PG8_SCHED;
            PG8_LDB(B0, 1, 0); PG8_LDB(B1, 1, 1); PG8_SCHED; PG8_LDA(At, 1, 0); PG8_STAGE(PG8_SA(0, 1), a2 + hstepA, voffA);
            PG8_WAIT_V(8); PG8_WAIT_L(0); PG8_BAR; PG8_MMA(0, 0, At, B0); PG8_MMA(0, 1, At, B1); PG8_BAR; PG8_SCHED;
            PG8_LDA(At, 1, 1); PG8_STAGE(PG8_SB(1, 0), b3, voffB); PG8_STAGE(PG8_SB(1, 1), b3 + hstepB, voffB); PG8_STAGE(PG8_SA(1, 0), a3, voffA);
            PG8_WAIT_V(8); PG8_WAIT_L(0); PG8_BAR; PG8_MMA(1, 0, At, B0); PG8_MMA(1, 1, At, B1); PG8_BAR; PG8_SCHED;
            } else {
            PG8_LDB(B0, 0, 0); PG8_SCHED; PG8_LDA(At, 0, 0); PG8_STAGE(PG8_SA(1, 1), a1 + hstepA, voffA);
            PG8_WAIT_L(8); PG8_BAR; PG8_WAIT_L(0); PG8_MMA(0, 0, At, B0); PG8_BAR; PG8_SCHED;
            PG8_LDB(B1, 0, 1); PG8_STAGE(PG8_SB(0, 0), b2, voffB);
            PG8_BAR; PG8_WAIT_L(0); PG8_MMA(0, 1, At, B1); PG8_BAR;
            PG8_LDA(At, 0, 1); PG8_STAGE(PG8_SA(0, 0), a2, voffA);
            PG8_BAR; PG8_WAIT_L(0); PG8_MMA(1, 0, At, B0); PG8_BAR; PG8_SCHED;
            PG8_STAGE(PG8_SB(0, 1), b2 + hstepB, voffB);
            PG8_WAIT_V(6); PG8_BAR; PG8_MMA(1, 1, At, B1); PG8_BAR;
            PG8_LDB(B0, 1, 0); PG8_SCHED; PG8_LDA(At, 1, 0); PG8_STAGE(PG8_SA(0, 1), a2 + hstepA, voffA);
            PG8_WAIT_L(8); PG8_BAR; PG8_WAIT_L(0); PG8_MMA(0, 0, At, B0); PG8_BAR; PG8_SCHED;
            PG8_LDB(B1, 1, 1); PG8_STAGE(PG8_SB(1, 0), b3, voffB);
            PG8_BAR; PG8_WAIT_L(0); PG8_MMA(0, 1, At, B1); PG8_BAR;
            PG8_LDA(At, 1, 1); PG8_STAGE(PG8_SA(1, 0), a3, voffA);
            PG8_BAR; PG8_WAIT_L(0); PG8_MMA(1, 0, At, B0); PG8_BAR; PG8_SCHED;
            PG8_STAGE(PG8_SB(1, 1), b3 + hstepB, voffB);
            PG8_WAIT_V(6); PG8_BAR; PG8_MMA(1, 1, At, B1); PG8_BAR;
            }
        }
        if constexpr (ALIGN_EPI) { if (wr == 0) PG8_BAR; }
        if constexpr (!Epi::AFTER_DRAIN) { E(acc, cur, wr, wc, fr, fq); S.done(cur); }
        if (!has_next) break;
#pragma unroll
        for (int a = 0; a < 2; ++a)
#pragma unroll
            for (int b = 0; b < 2; ++b)
#pragma unroll
                for (int m = 0; m < 4; ++m)
#pragma unroll
                    for (int n = 0; n < 2; ++n) acc[a][b][m][n] = (f32x4){0.f, 0.f, 0.f, 0.f};
        cur = nxt; cA = nA; cB = nB; ++ui;
        if constexpr (ALIGN_EPI) { if (wr == 1) PG8_BAR; }
    }
    PG8_WAIT_V(0);
    if constexpr (!ALIGN_EPI) { if (wr == 0) PG8_BAR; }
    PG8_BAR;
    if constexpr (Epi::AFTER_DRAIN) { E.fused(acc, cur, wr, wc, fr, fq, lds, wid, lane); S.done(cur); }
#undef PG8_KOFFA
#undef PG8_SA
#undef PG8_SB
#undef PG8_STAGE
#undef PG8_LDA
#undef PG8_LDB
#undef PG8_MMA
#undef PG8_WAIT_V
#undef PG8_WAIT_L
#undef PG8_BAR
#undef PG8_SCHED
}
}
namespace mix {
#define LAS __attribute__((address_space(3)))
typedef unsigned short bf16_t;
typedef short bf16x8 __attribute__((ext_vector_type(8)));
typedef short s16x4 __attribute__((ext_vector_type(4)));
typedef short v4i16_t __attribute__((ext_vector_type(4)));
typedef float f32x16 __attribute__((ext_vector_type(16)));
typedef float f32x4 __attribute__((ext_vector_type(4)));
typedef unsigned u32x4 __attribute__((ext_vector_type(4)));
typedef unsigned u32x2 __attribute__((ext_vector_type(2)));
typedef float f32x2_t __attribute__((ext_vector_type(2))); typedef __bf16 bf16x2_t __attribute__((ext_vector_type(2)));
constexpr int ZP = 3584, SEQ = 4096;
constexpr int KBUF = 32768;
constexpr int EXP = 132;
constexpr int QF_OFF = 98304;
constexpr int WSF_OFF = 131072;
constexpr float LOG2E = 1.4426950408889634f;
__device__ __forceinline__ int crow(int r, int hi) { return (r & 3) + 8 * (r >> 2) + 4 * hi; }
__device__ __forceinline__ unsigned cvtpk(float lo, float hi) { f32x2_t v = {lo, hi}; bf16x2_t b = __builtin_convertvector(v, bf16x2_t); return __builtin_bit_cast(unsigned, b); }
__device__ __forceinline__ float bf2f(unsigned short b) { return __uint_as_float((unsigned)b << 16); }
__device__ __forceinline__ float bflo(unsigned w) { return __uint_as_float(w << 16); }
__device__ __forceinline__ float bfhi(unsigned w) { return __uint_as_float(w & 0xffff0000u); }
__device__ __forceinline__ s16x4 vtr(const LAS unsigned char* p) { return __builtin_bit_cast(s16x4, __builtin_amdgcn_ds_read_tr16_b64_v4i16((LAS v4i16_t*)p)); }
__device__ __forceinline__ float swap32(float v) { auto rr = __builtin_amdgcn_permlane32_swap(__float_as_uint(v), __float_as_uint(v), false, false); return (__builtin_amdgcn_mbcnt_lo(~0u, 0u) & 32) ? __uint_as_float(rr[0]) : __uint_as_float(rr[1]); }
__device__ __forceinline__ float silu(float x) { return x * __builtin_amdgcn_rcpf(1.0f + __builtin_amdgcn_exp2f(-x * LOG2E)); }
__device__ __forceinline__ unsigned vtr_off(int lane, int cc, int t) {
    const int hi = lane >> 5, blk = (lane >> 4) & 1, q4 = (lane & 15) >> 2, p = lane & 3;
    return 256u * (4 * hi + 8 * t + q4) + 16u * (((cc ^ q4) << 2) | ((2 * blk + (p >> 1)) ^ (hi + 2 * t))) + 8u * (p & 1);
}
__device__ __forceinline__ void glds16(const void* gsrc, unsigned lds_dst) {
    asm volatile("s_mov_b32 m0, %1\n\ts_nop 0\n\tglobal_load_lds_dwordx4 %0, off" :: "v"(gsrc), "s"(lds_dst) : "memory", "m0"); }
__device__ __forceinline__ unsigned vst_off(int row, int ch) { return 256u * row + 16u * (ch ^ (((row & 3) << 2) | ((row >> 2) & 3))); }

__device__ __forceinline__ int att_tile(int i, int d0, int nl) { const int j = i - 2; const int tl = d0 - 1 - j, tr = d0 + i - nl; int t = (j < nl) ? tl : tr; t = (i < 2) ? d0 + i : t; return t; }
__device__ __forceinline__ void attn_unit(LAS unsigned char* lds, bf16_t* Z, int b, int h, int qb, float slope2, float lam, float oml, const float* subg, const int wave_in, const int W, const bool track, const bool first, const bool has_next, const int bN, const int hN, const int qbN, bool dry = false) {
    int tid_ = wave_in * 64 + lane_now(); asm volatile("" : "+v"(tid_));
    const int tid = tid_, lane = tid & 63, r32 = lane & 31, hi = lane >> 5; const int wid = __builtin_amdgcn_readfirstlane(tid >> 6);
    const int c = wid >> 2, qs = wid & 3;
    const size_t rowbase = (size_t)b * SEQ;
    bf16x8 qf[4];
    { const bf16_t* Qw = Z + (rowbase + qb * 128 + qs * 32 + r32) * ZP + h * 128 + c * 64 + hi * 8;
#pragma unroll
      for (int s = 0; s < 4; ++s) qf[s] = *(const bf16x8*)(Qw + s * 16); }
    const int vrow0 = 8 * wid + (lane >> 4), vrow1 = vrow0 + 4;
    const bf16_t* vg0 = Z + (rowbase + vrow0) * ZP + 1024 + h * 128 + ((lane & 15) ^ (((vrow0 & 3) << 2) | ((vrow0 >> 2) & 3))) * 8;
    const bf16_t* vg1 = Z + (rowbase + vrow1) * ZP + 1024 + h * 128 + ((lane & 15) ^ (((vrow1 & 3) << 2) | ((vrow1 >> 2) & 3))) * 8;
    const bf16_t* kg0 = vg0 - 512; const bf16_t* kg1 = vg1 - 512;
    unsigned kaddr[4], vaddr[4][2];
#pragma unroll
    for (int s = 0; s < 4; ++s) kaddr[s] = vst_off(r32, c * 8 + 2 * s + hi);
#pragma unroll
    for (int cc = 0; cc < 4; ++cc) { vaddr[cc][0] = 49152u + vtr_off(lane, cc, 0); vaddr[cc][1] = 49152u + vtr_off(lane, cc, 1); }
    LAS float* wsf = (LAS float*)(lds + WSF_OFF) + wid * 64;
    const unsigned lds0 = (unsigned)(uintptr_t)lds;
    const int q0w = qb * 128 + qs * 32, qpos = q0w + r32;
    bf16x8 kaug[2];
    { u32x4 w; w.y = hi ? 0x00003F80u : 0u; w.z = 0u; w.w = 0u;
      const unsigned k0b = __float_as_uint((float)r32) >> 16, k1b = __float_as_uint((float)(32 + r32)) >> 16;
      w.x = hi ? 0x3F803F80u : (k0b | (k0b << 16)); kaug[0] = __builtin_bit_cast(bf16x8, w);
      w.x = hi ? 0x3F803F80u : (k1b | (k1b << 16)); kaug[1] = __builtin_bit_cast(bf16x8, w); }
    unsigned slw;
    { const unsigned sh = cvtpk(slope2, 0.f) & 0xffffu; const float shf = __uint_as_float(sh << 16); const unsigned sl = cvtpk(slope2 - shf, 0.f) & 0xffffu; slw = sh | (sl << 16); }
    bf16x8 ones; { u32x4 w; w.x = w.y = w.z = w.w = 0x3F803F80u; ones = __builtin_bit_cast(bf16x8, w); }
    f32x16 ol = f32x16{};
    const int d0 = 2 * qb;
    float mhat = 0.f; f32x16 o[4]; const f32x16 zero16 = f32x16{};
#pragma unroll
    for (int cc = 0; cc < 4; ++cc) o[cc] = f32x16{};
    const int nl = (d0 < W) ? d0 : W, nr = (62 - d0 < W) ? 62 - d0 : W, NT = 2 + nl + nr;
#define ATT_TILE(i) att_tile((i), d0, nl)
#define ATT_DMAK_(k0p, k1p, tile, slot) do { const size_t go = (size_t)(tile) * 64 * ZP; const unsigned bb = lds0 + (slot) * 16384 + wid * 2048; \
        glds16((k0p) + go, (unsigned)__builtin_amdgcn_readfirstlane(bb)); glds16((k1p) + go, (unsigned)__builtin_amdgcn_readfirstlane(bb + 1024)); } while (0)
#define ATT_DMAK(tile, slot) ATT_DMAK_(kg0, kg1, tile, slot)
#define ATT_DMAV_(v0p, v1p, tile, slot) do { const size_t go = (size_t)(tile) * 64 * ZP; const unsigned bb = lds0 + 49152 + (slot) * 16384 + wid * 2048; \
        glds16((v0p) + go, (unsigned)__builtin_amdgcn_readfirstlane(bb)); glds16((v1p) + go, (unsigned)__builtin_amdgcn_readfirstlane(bb + 1024)); } while (0)
#define ATT_DMAV(tile, slot) ATT_DMAV_(vg0, vg1, tile, slot)
#define ATT_BAR() do { asm volatile("s_waitcnt vmcnt(0)" ::: "memory"); __syncthreads(); } while (0)
#define ATT_BAR4() do { asm volatile("s_waitcnt vmcnt(4)" ::: "memory"); __syncthreads(); } while (0)
#define MX3(a, b, c) __builtin_fmaxf(__builtin_fmaxf((a), (b)), (c))
#define ATT_QAUG(dst, kvs) do { const float sg_ = ((kvs) <= q0w) ? 1.0f : -1.0f; const float x_ = __builtin_fmaf(sg_ * slope2, (float)((tile_) * 64 - qpos), -mhat); \
        const unsigned wa_ = cvtpk(x_, x_); const float r1_ = x_ - __uint_as_float(wa_ & 0xffff0000u); const unsigned wb_ = cvtpk(r1_, r1_); const float r2_ = r1_ - __uint_as_float(wb_ & 0xffff0000u); \
        const unsigned wc_ = cvtpk(r2_, 0.f); u32x4 w_; w_.x = hi ? ((wa_ & 0xffffu) | (wb_ & 0xffff0000u)) : (((kvs) <= q0w) ? slw : (slw ^ 0x80008000u)); w_.y = hi ? wc_ : 0u; w_.z = 0u; w_.w = 0u; dst = __builtin_bit_cast(bf16x8, w_); } while (0)
#define ATT_QK(tile, kslot) do { const int tile_ = (tile); const LAS unsigned char* kb_ = lds + (kslot) * 16384; bf16x8 kf_[8]; \
        _Pragma("unroll") for (int s = 0; s < 4; ++s) { kf_[2 * s] = *(const LAS bf16x8*)(kb_ + kaddr[s]); kf_[2 * s + 1] = *(const LAS bf16x8*)(kb_ + kaddr[s] + 8192); } \
        bf16x8 qa0_, qa1_; ATT_QAUG(qa0_, tile_ * 64); ATT_QAUG(qa1_, tile_ * 64 + 32); \
        s0 = __builtin_amdgcn_mfma_f32_32x32x16_bf16(kaug[0], qa0_, zero16, 0, 0, 0); s1 = __builtin_amdgcn_mfma_f32_32x32x16_bf16(kaug[1], qa1_, zero16, 0, 0, 0); \
        _Pragma("unroll") for (int s = 0; s < 4; ++s) { s0 = __builtin_amdgcn_mfma_f32_32x32x16_bf16(kf_[2 * s], qf[s], s0, 0, 0, 0); s1 = __builtin_amdgcn_mfma_f32_32x32x16_bf16(kf_[2 * s + 1], qf[s], s1, 0, 0, 0); } \
        if (tile_ == d0 + (qs >> 1)) { const float m2_ = -2.0f * slope2; \
            if (qs & 1) { _Pragma("unroll") for (int r = 0; r < 16; ++r) s1[r] = __builtin_fmaf(m2_, __builtin_fmaxf((float)(crow(r, hi) - r32), 0.f), s1[r]); } \
            else { _Pragma("unroll") for (int r = 0; r < 16; ++r) s0[r] = __builtin_fmaf(m2_, __builtin_fmaxf((float)(crow(r, hi) - r32), 0.f), s0[r]); } } } while (0)
#define ATT_QK_OFF(tile, kslot) do { const int tile_ = (tile); const LAS unsigned char* kb_ = lds + (kslot) * 16384; bf16x8 kf_[8]; \
        _Pragma("unroll") for (int s = 0; s < 4; ++s) { kf_[2 * s] = *(const LAS bf16x8*)(kb_ + kaddr[s]); kf_[2 * s + 1] = *(const LAS bf16x8*)(kb_ + kaddr[s] + 8192); } \
        bf16x8 qa0_; ATT_QAUG(qa0_, tile_ * 64); \
        s0 = __builtin_amdgcn_mfma_f32_32x32x16_bf16(kaug[0], qa0_, zero16, 0, 0, 0); s1 = __builtin_amdgcn_mfma_f32_32x32x16_bf16(kaug[1], qa0_, zero16, 0, 0, 0); \
        _Pragma("unroll") for (int s = 0; s < 4; ++s) { s0 = __builtin_amdgcn_mfma_f32_32x32x16_bf16(kf_[2 * s], qf[s], s0, 0, 0, 0); s1 = __builtin_amdgcn_mfma_f32_32x32x16_bf16(kf_[2 * s + 1], qf[s], s1, 0, 0, 0); } } while (0)
#define ATT_ROWMAX(rm) do { float a_ = MX3(s0[0], s0[1], s1[0]), b_ = MX3(s0[2], s0[3], s1[1]); a_ = MX3(a_, s1[2], s1[3]); \
        _Pragma("unroll") for (int r = 4; r < 16; r += 4) { a_ = MX3(a_, s0[r], s0[r + 1]); b_ = MX3(b_, s0[r + 2], s0[r + 3]); a_ = MX3(a_, s1[r], s1[r + 1]); b_ = MX3(b_, s1[r + 2], s1[r + 3]); } \
        rm = __builtin_fmaxf(a_, b_); rm = __builtin_fmaxf(rm, swap32(rm)); } while (0)
#define ATT_RESC_CHECK(rm) do { if (__any(rm > 8.0f)) { const float dl = __builtin_fmaxf(rm, 0.f); mhat += dl; \
        _Pragma("unroll") for (int r = 0; r < 16; ++r) { s0[r] -= dl; s1[r] -= dl; } \
        const float f = __builtin_amdgcn_exp2f(-dl); wsf[r32] = f; resc = true; } } while (0)
#define ATT_EXP_PACK() do { \
        _Pragma("unroll") for (int r = 0; r < 16; ++r) { s0[r] = __builtin_amdgcn_exp2f(s0[r]); s1[r] = __builtin_amdgcn_exp2f(s1[r]); } \
        u32x4 w; \
        w.x = cvtpk(s0[0], s0[1]); w.y = cvtpk(s0[2], s0[3]); w.z = cvtpk(s0[4], s0[5]); w.w = cvtpk(s0[6], s0[7]); pf[0] = __builtin_bit_cast(bf16x8, w); \
        w.x = cvtpk(s0[8], s0[9]); w.y = cvtpk(s0[10], s0[11]); w.z = cvtpk(s0[12], s0[13]); w.w = cvtpk(s0[14], s0[15]); pf[1] = __builtin_bit_cast(bf16x8, w); \
        w.x = cvtpk(s1[0], s1[1]); w.y = cvtpk(s1[2], s1[3]); w.z = cvtpk(s1[4], s1[5]); w.w = cvtpk(s1[6], s1[7]); pf[2] = __builtin_bit_cast(bf16x8, w); \
        w.x = cvtpk(s1[8], s1[9]); w.y = cvtpk(s1[10], s1[11]); w.z = cvtpk(s1[12], s1[13]); w.w = cvtpk(s1[14], s1[15]); pf[3] = __builtin_bit_cast(bf16x8, w); } while (0)
#define ATT_RESC_APPLY() do { if (resc) { asm volatile("s_waitcnt lgkmcnt(0)" ::: "memory"); __builtin_amdgcn_wave_barrier(); \
        _Pragma("unroll") for (int k = 0; k < 4; ++k) { const f32x4 fv_ = *(const LAS f32x4*)(wsf + 8 * k + 4 * hi); \
            _Pragma("unroll") for (int cc = 0; cc < 4; ++cc) { o[cc][4 * k + 0] *= fv_[0]; o[cc][4 * k + 1] *= fv_[1]; o[cc][4 * k + 2] *= fv_[2]; o[cc][4 * k + 3] *= fv_[3]; } \
            ol[4 * k + 0] *= fv_[0]; ol[4 * k + 1] *= fv_[1]; ol[4 * k + 2] *= fv_[2]; ol[4 * k + 3] *= fv_[3]; } \
        asm volatile("s_waitcnt lgkmcnt(0)" ::: "memory"); __builtin_amdgcn_wave_barrier(); } } while (0)
#define ATT_VRD(dst, vb_, cc) do { _Pragma("unroll") for (int ks = 0; ks < 4; ++ks) { dst[2 * ks] = vtr(vb_ + vaddr[cc][0] + ks * 4096); dst[2 * ks + 1] = vtr(vb_ + vaddr[cc][1] + ks * 4096); } } while (0)
#define ATT_VF(src, ks) (bf16x8){src[2 * (ks)][0], src[2 * (ks)][1], src[2 * (ks)][2], src[2 * (ks)][3], src[2 * (ks) + 1][0], src[2 * (ks) + 1][1], src[2 * (ks) + 1][2], src[2 * (ks) + 1][3]}
#define ATT_PV(cc, src) do { _Pragma("unroll") for (int ks = 0; ks < 4; ++ks) o[cc] = __builtin_amdgcn_mfma_f32_32x32x16_bf16(pf[ks], ATT_VF(src, ks), o[cc], 0, 0, 0); } while (0)
    f32x16 s0, s1; bf16x8 pf[4]; bool resc = false;
    if (c == 0) __builtin_amdgcn_s_setprio(1);
    {
        if (first) { ATT_DMAK(ATT_TILE(0), 0); ATT_DMAV(ATT_TILE(0), 0); ATT_DMAK(ATT_TILE(1), 1); }
        { const int i2 = (2 < NT) ? 2 : NT - 1; const int t2 = ATT_TILE(i2); ATT_DMAK(t2, 2); ATT_DMAV(ATT_TILE(1), 1); } }
    ATT_BAR4();
    { ATT_QK(ATT_TILE(0), 0); if (track) { float rm; ATT_ROWMAX(rm); ATT_RESC_CHECK(rm); } ATT_EXP_PACK(); resc = false; }
    ATT_BAR();
#define ATT_PVC(cc, src) do { _Pragma("unroll") for (int ks = 0; ks < 4; ++ks) o[cc] = __builtin_amdgcn_mfma_f32_32x32x16_bf16(pc[ks], ATT_VF(src, ks), o[cc], 0, 0, 0); } while (0)
#define ATT_LSUM() do { _Pragma("unroll") for (int ks = 0; ks < 4; ++ks) ol = __builtin_amdgcn_mfma_f32_32x32x16_bf16(pc[ks], ones, ol, 0, 0, 0); } while (0)
    int m3 = 0;
    {
        const int i = 0;
        const int m3p1 = (m3 == 2) ? 0 : m3 + 1, m3p2 = (m3 == 0) ? 2 : m3 - 1;
        { const int i3 = __builtin_elementwise_min(i + 3, NT - 1); const int t3 = ATT_TILE(i3); ATT_DMAK(t3, m3); }
        { const int i2 = __builtin_elementwise_min(i + 2, NT - 1); const int t2 = ATT_TILE(i2); ATT_DMAV(t2, m3p2); }
        const int t1 = ATT_TILE(i + 1);
        const LAS unsigned char* vb = lds + m3 * 16384;
        s16x4 va[8], vbb[8];
        bf16x8 pc[4];
#pragma unroll
        for (int k = 0; k < 4; ++k) pc[k] = pf[k];
        ATT_VRD(va, vb, 0);
        ATT_QK(t1, m3p1);
        ATT_VRD(vbb, vb, 1);
        if (track) { float rm; ATT_ROWMAX(rm); ATT_RESC_CHECK(rm); }
        ATT_PVC(0, va);
        ATT_VRD(va, vb, 2);
        ATT_PVC(1, vbb);
        ATT_VRD(vbb, vb, 3);
        ATT_EXP_PACK();
        ATT_PVC(2, va);
        ATT_LSUM();
        ATT_PVC(3, vbb);
        asm volatile("" : "+v"(pf[0]), "+v"(pf[1]), "+v"(pf[2]), "+v"(pf[3]));
#pragma unroll
        for (int g_ = 0; g_ < 16; ++g_) { __builtin_amdgcn_sched_group_barrier(0x008, 1, 0); __builtin_amdgcn_sched_group_barrier(0x002, 3, 0); __builtin_amdgcn_sched_group_barrier(0x100, 1, 0); }
        __builtin_amdgcn_sched_group_barrier(0x008, 4, 0);
        ATT_RESC_APPLY(); resc = false;
        ATT_BAR4();
        m3 = m3p1;
    }
    for (int i = 1; i < NT - 1; ++i) {
        const int m3p1 = (m3 == 2) ? 0 : m3 + 1, m3p2 = (m3 == 0) ? 2 : m3 - 1;
        { const int i3 = __builtin_elementwise_min(i + 3, NT - 1); const int t3 = ATT_TILE(i3); ATT_DMAK(t3, m3); }
        { const int i2 = __builtin_elementwise_min(i + 2, NT - 1); const int t2 = ATT_TILE(i2); ATT_DMAV(t2, m3p2); }
        const int t1 = ATT_TILE(i + 1);
        const LAS unsigned char* vb = lds + m3 * 16384;
        s16x4 va[8], vbb[8];
        bf16x8 pc[4];
#pragma unroll
        for (int k = 0; k < 4; ++k) pc[k] = pf[k];
        ATT_VRD(va, vb, 0);
        ATT_QK_OFF(t1, m3p1);
        ATT_VRD(vbb, vb, 1);
        if (track) { float rm; ATT_ROWMAX(rm); ATT_RESC_CHECK(rm); }
        ATT_PVC(0, va);
        ATT_VRD(va, vb, 2);
        ATT_PVC(1, vbb);
        ATT_VRD(vbb, vb, 3);
        ATT_EXP_PACK();
        ATT_PVC(2, va);
        ATT_LSUM();
        ATT_PVC(3, vbb);
        asm volatile("" : "+v"(pf[0]), "+v"(pf[1]), "+v"(pf[2]), "+v"(pf[3]));
#pragma unroll
        for (int g_ = 0; g_ < 16; ++g_) { __builtin_amdgcn_sched_group_barrier(0x008, 1, 0); __builtin_amdgcn_sched_group_barrier(0x002, 3, 0); __builtin_amdgcn_sched_group_barrier(0x100, 1, 0); }
        __builtin_amdgcn_sched_group_barrier(0x008, 4, 0);
        ATT_RESC_APPLY(); resc = false;
        ATT_BAR4();
        m3 = m3p1;
    }
    {
        const LAS unsigned char* vb = lds + m3 * 16384;
        s16x4 va[8], vbb[8]; bf16x8 pc[4];
#pragma unroll
        for (int k = 0; k < 4; ++k) pc[k] = pf[k];
        ATT_VRD(va, vb, 0); ATT_VRD(vbb, vb, 1); ATT_PVC(0, va); ATT_VRD(va, vb, 2); ATT_PVC(1, vbb); ATT_VRD(vbb, vb, 3); ATT_PVC(2, va); ATT_LSUM(); ATT_PVC(3, vbb);
        ATT_BAR();
    }
    __builtin_amdgcn_s_setprio(0);
    if (has_next) {
        const size_t rbN = (size_t)bN * SEQ; const int d0N = 2 * qbN;
        const bf16_t* vgN0 = Z + (rbN + vrow0) * ZP + 1024 + hN * 128 + ((lane & 15) ^ (((vrow0 & 3) << 2) | ((vrow0 >> 2) & 3))) * 8;
        const bf16_t* vgN1 = Z + (rbN + vrow1) * ZP + 1024 + hN * 128 + ((lane & 15) ^ (((vrow1 & 3) << 2) | ((vrow1 >> 2) & 3))) * 8;
        ATT_DMAK_(vgN0 - 512, vgN1 - 512, d0N, 0); ATT_DMAV_(vgN0, vgN1, d0N, 0); ATT_DMAK_(vgN0 - 512, vgN1 - 512, d0N + 1, 1);
    }
#undef ATT_TILE
#undef ATT_DMAK
#undef ATT_DMAK_
#undef ATT_DMAV_
#undef ATT_BAR
#undef ATT_BAR4
#undef ATT_DMAV
#undef ATT_QK
#undef ATT_QK_OFF
#undef ATT_ROWMAX
#undef ATT_RESC_CHECK
#undef ATT_EXP_PACK
#undef ATT_RESC_APPLY
#undef ATT_VRD
#undef ATT_VF
#undef ATT_PV
#undef ATT_PVC
#undef ATT_LSUM
#undef ATT_QAUG
#undef MX3
    u32x2 gpre[8];
#pragma unroll
    for (int it = 0; it < 8; ++it) gpre[it] = *(const u32x2*)(Z + (rowbase + qb * 128 + wid * 16 + 2 * it + hi) * ZP + h * 128 + 4 * r32 + 1536);
    f32x4 fv[4];
    { const float lc = (c == 0) ? 1.0f : -lam;
#pragma unroll
      for (int k = 0; k < 4; ++k) { fv[k][0] = lc * __builtin_amdgcn_rcpf(ol[4 * k + 0]); fv[k][1] = lc * __builtin_amdgcn_rcpf(ol[4 * k + 1]); fv[k][2] = lc * __builtin_amdgcn_rcpf(ol[4 * k + 2]); fv[k][3] = lc * __builtin_amdgcn_rcpf(ol[4 * k + 3]); } }
    LAS float* Ex = (LAS float*)(lds + 65536);
    if (c == 1) {
#pragma unroll
        for (int cc = 0; cc < 4; ++cc)
#pragma unroll
            for (int r = 0; r < 16; ++r) Ex[(qs * 32 + crow(r, hi)) * EXP + cc * 32 + r32] = o[cc][r] * fv[r >> 2][r & 3];
    }
    __syncthreads();
    if (c == 0) {
#pragma unroll
        for (int cc = 0; cc < 4; ++cc)
#pragma unroll
            for (int r = 0; r < 16; ++r) { LAS float* p = Ex + (qs * 32 + crow(r, hi)) * EXP + cc * 32 + r32; *p = *p + o[cc][r] * fv[r >> 2][r & 3]; }
    }
    __syncthreads();
    { const f32x4 sg = *(const f32x4*)(subg + 4 * r32);
#pragma unroll
      for (int it = 0; it < 8; ++it) { const int row = wid * 16 + 2 * it + hi;
        const f32x4 v = *(const LAS f32x4*)(Ex + row * EXP + 4 * r32);
        float ss = (v[0] * v[0] + v[1] * v[1]) + (v[2] * v[2] + v[3] * v[3]);
        ss += __shfl_xor(ss, 1); ss += __shfl_xor(ss, 2); ss += __shfl_xor(ss, 4); ss += __shfl_xor(ss, 8); ss += __shfl_xor(ss, 16);
        const float rs = __builtin_amdgcn_rsqf(ss * (1.0f / 128.0f) + 1e-6f) * oml;
        bf16_t* zr = Z + (rowbase + qb * 128 + row) * ZP + h * 128 + 4 * r32;
        const u32x2 gw = gpre[it];
        const float o0 = v[0] * rs * sg[0] * silu(bflo(gw.x)), o1 = v[1] * rs * sg[1] * silu(bfhi(gw.x)), o2 = v[2] * rs * sg[2] * silu(bflo(gw.y)), o3 = v[3] * rs * sg[3] * silu(bfhi(gw.y));
        u32x2 ow; ow.x = cvtpk(o0, o1); ow.y = cvtpk(o2, o3); if (!dry) *(u32x2*)zr = ow; } }
    __syncthreads();
}

__device__ __forceinline__ void sgu_unit(LAS unsigned char* lds, bf16_t* Z, int b, int chunk, const float* vng, const bf16_t* Wsb, const float* bs, const int wave_in, bool dry = false) {
    int tid_ = wave_in * 64 + lane_now(); asm volatile("" : "+v"(tid_));
    const int tid = tid_, lane = tid & 63, r32 = lane & 31, hi = lane >> 5; const int wid = __builtin_amdgcn_readfirstlane(tid >> 6);
    const size_t rowbase = (size_t)b * SEQ + (size_t)chunk * 128;
    { f32x4 g0 = *(const f32x4*)(vng + lane * 8), g1 = *(const f32x4*)(vng + lane * 8 + 4);
#pragma unroll 8
      for (int it = 0; it < 16; ++it) { const int row = wid * 16 + it;
        const u32x4 raw = *(const u32x4*)(Z + (rowbase + row) * ZP + 2560 + lane * 8);
        float x[8] = {bflo(raw.x), bfhi(raw.x), bflo(raw.y), bfhi(raw.y), bflo(raw.z), bfhi(raw.z), bflo(raw.w), bfhi(raw.w)};
        float ss = 0.f;
#pragma unroll
        for (int j = 0; j < 8; ++j) ss += x[j] * x[j];
#pragma unroll
        for (int of = 1; of < 64; of <<= 1) ss += __shfl_xor(ss, of);
        const float rs = __builtin_amdgcn_rsqf(ss * (1.0f / 512.0f) + 1e-6f);
        u32x4 w; w.x = cvtpk(x[0] * rs * g0[0], x[1] * rs * g0[1]); w.y = cvtpk(x[2] * rs * g0[2], x[3] * rs * g0[3]); w.z = cvtpk(x[4] * rs * g1[0], x[5] * rs * g1[1]); w.w = cvtpk(x[6] * rs * g1[2], x[7] * rs * g1[3]);
        *(LAS u32x4*)(lds + (lane >> 4) * 32768 + vst_off(row, lane & 15)) = w; } }
    __syncthreads();
    const int tb = wid & 3, dh = wid >> 2;
    unsigned va[2][2];
#pragma unroll
    for (int c2 = 0; c2 < 2; ++c2) { va[c2][0] = vtr_off(lane, dh * 2 + c2, 0); va[c2][1] = vtr_off(lane, dh * 2 + c2, 1); }
    for (int g = 0; g < 4; ++g) {
        bf16x8 af[8];
        { const bf16_t* wp = Wsb + ((size_t)(g * 128 + tb * 32 + r32)) * 128 + 4 * hi;
#pragma unroll
          for (int ks = 0; ks < 8; ++ks) { const u32x2 lo = *(const u32x2*)(wp + 16 * ks), hh = *(const u32x2*)(wp + 16 * ks + 8); u32x4 w; w.x = lo.x; w.y = lo.y; w.z = hh.x; w.w = hh.y; af[ks] = __builtin_bit_cast(bf16x8, w); } }
        f32x16 acc[2]; acc[0] = f32x16{}; acc[1] = f32x16{};
        const LAS unsigned char* tbp = lds + g * 32768;
#pragma unroll
        for (int c2 = 0; c2 < 2; ++c2)
#pragma unroll
            for (int ks = 0; ks < 8; ++ks) { const s16x4 lo = vtr(tbp + va[c2][0] + ks * 4096), hh = vtr(tbp + va[c2][1] + ks * 4096);
                const bf16x8 vf = (bf16x8){lo[0], lo[1], lo[2], lo[3], hh[0], hh[1], hh[2], hh[3]};
                acc[c2] = __builtin_amdgcn_mfma_f32_32x32x16_bf16(af[ks], vf, acc[c2], 0, 0, 0); }
        unsigned short uu_[2][16], gg_[2][16];
#pragma unroll
        for (int c2 = 0; c2 < 2; ++c2)
#pragma unroll
            for (int r = 0; r < 16; ++r) { const int t = tb * 32 + crow(r, hi); const int col = g * 128 + (dh * 2 + c2) * 32 + r32;
                const bf16_t* zp = Z + (rowbase + t) * ZP + 2048 + col; uu_[c2][r] = zp[0]; gg_[c2][r] = zp[1024]; }
#pragma unroll
        for (int c2 = 0; c2 < 2; ++c2)
#pragma unroll
            for (int r = 0; r < 16; ++r) { const int t = tb * 32 + crow(r, hi); const int col = g * 128 + (dh * 2 + c2) * 32 + r32;
                bf16_t* zp = Z + (rowbase + t) * ZP + 2048 + col;
                const float sv = acc[c2][r] + bs[g * 128 + t];
                const float ov = bf2f(uu_[c2][r]) * sv * silu(bf2f(gg_[c2][r]));
                if (!dry) zp[0] = (bf16_t)(cvtpk(ov, 0.f) & 0xffffu); }
    }
    __syncthreads();
}
#undef LAS
}
#define LAS __attribute__((address_space(3)))
typedef unsigned short bf16;
typedef unsigned v4u __attribute__((ext_vector_type(4)));
typedef float f32x4 __attribute__((ext_vector_type(4)));
constexpr int NWAVES = 8, NTHREADS = 512;
constexpr int DM = 1024, DIN = 3584, DEPTH = 4, SEQ = 4096, NB_P = 8, NB_S = 16, NB = 24;
constexpr int M = NB * SEQ;
constexpr int M_P = NB_P * SEQ;
constexpr size_t MiB = 1u << 20;
constexpr size_t WS_MISC = 0;
constexpr size_t WS_HMAX = 65536;
constexpr size_t WS_WIN = 1 * MiB;
constexpr size_t WS_WOUT = 30 * MiB;
constexpr size_t WS_WS = 39 * MiB;
constexpr size_t WS_SSQ = 40 * MiB;
constexpr size_t WS_XB = 44 * MiB;
constexpr size_t WS_Z = 240 * MiB;
constexpr size_t WS_END = WS_Z + (size_t)M * DIN * 2;
static_assert(WS_XB + (size_t)M * DM * 2 <= WS_Z && WS_END <= (size_t)1024 * MiB, "d_ws map");
constexpr int LDS_BYTES = 139264;

__device__ __forceinline__ unsigned f2bf(float f) { unsigned u = __builtin_bit_cast(unsigned, f); return (u + 0x7fffu + ((u >> 16) & 1u)) >> 16; }
__device__ __forceinline__ unsigned pk2(float lo, float hi) { return f2bf(lo) | (f2bf(hi) << 16); }
__device__ __forceinline__ float wave_sum(float v) {
#pragma unroll
    for (int o = 1; o < 64; o <<= 1) v += __shfl_xor(v, o);
    return v;
}
__device__ __forceinline__ void transpose_item(const float* W, int K, int N, bf16* WT, const float* gsc, LAS float* scr, int item, int lane) {
    const int nblk = N / 32, kb = item / nblk, nb = item % nblk, k0 = 64 * kb, n0 = 32 * nb;
#pragma unroll 8
    for (int i = 0; i < 32; ++i) { const int kk = 2 * i + (lane >> 5); const float sc = gsc ? gsc[k0 + kk] : 1.0f; scr[kk * 33 + (lane & 31)] = W[(size_t)(k0 + kk) * N + n0 + (lane & 31)] * sc; }
    asm volatile("s_waitcnt lgkmcnt(0)" ::: "memory");
    const int c = lane & 7;
#pragma unroll
    for (int j = 0; j < 4; ++j) { const int n = (lane >> 3) + 8 * j; const LAS float* s = scr + (8 * c) * 33 + n;
        v4u o; o.x = pk2(s[0 * 33], s[1 * 33]); o.y = pk2(s[2 * 33], s[3 * 33]); o.z = pk2(s[4 * 33], s[5 * 33]); o.w = pk2(s[6 * 33], s[7 * 33]);
        *(v4u*)(WT + (size_t)(n0 + n) * K + k0 + 8 * c) = o; }
    asm volatile("s_waitcnt lgkmcnt(0)" ::: "memory");
}

struct Args { const float* xp; const float* xs; const float* norm_g; const float* w_in; const float* lambda_qk; const float* subln_g; const float* vnorm_g;
              const float* w_s; const float* b_s; const float* w_out; const float* final_g; float* out; unsigned char* ws; };

__global__ void __launch_bounds__(NTHREADS) hymba_fwd(Args a) {
    extern __shared__ __attribute__((aligned(16))) unsigned char lds_raw[];
    LAS unsigned char* lds = (LAS unsigned char*)lds_raw;
    cg::grid_group grid = cg::this_grid();
    const int tid = threadIdx.x, lane = tid & 63; const int wave = __builtin_amdgcn_readfirstlane(tid >> 6);
    const int G = gridDim.x, bx = blockIdx.x;
    const int vcu = (G % 8 == 0) ? (bx % 8) * (G / 8) + bx / 8 : bx;
    unsigned char* ws = a.ws;
    float* misc = (float*)(ws + WS_MISC);
    unsigned* hmax = (unsigned*)(ws + WS_HMAX);
    bf16* WinT = (bf16*)(ws + WS_WIN); bf16* WoutT = (bf16*)(ws + WS_WOUT); bf16* Wsb = (bf16*)(ws + WS_WS);
    unsigned long long* ssq = (unsigned long long*)(ws + WS_SSQ);
    bf16* XB = (bf16*)(ws + WS_XB); bf16* Z = (bf16*)(ws + WS_Z);

    {
        const int gw = vcu * NWAVES + wave, NGW = G * NWAVES;
        LAS float* scr = (LAS float*)(lds + wave * 16384);
        constexpr int I_IN = (DM / 64) * (DIN / 32), I_OUT = (DM / 64) * (DM / 32), I_L = I_IN + I_OUT;
        for (int it = gw; it < DEPTH * I_L; it += NGW) { const int l = it / I_L; int r = it % I_L;
            if (r < I_IN) transpose_item(a.w_in + (size_t)l * DM * DIN, DM, DIN, WinT + (size_t)l * DIN * DM, a.norm_g + l * DM, scr, r, lane);
            else transpose_item(a.w_out + (size_t)l * DM * DM, DM, DM, WoutT + (size_t)l * DM * DM, nullptr, scr, r - I_IN, lane); }
        for (int i = (bx * NTHREADS + tid); i < DEPTH * 4 * 128 * 128 / 2; i += G * NTHREADS) { const float2 v = ((const float2*)a.w_s)[i]; ((unsigned*)Wsb)[i] = pk2(v.x, v.y); }
        for (int i = (bx * NTHREADS + tid); i < 4 * M; i += G * NTHREADS) ssq[M + i] = 0ull;
        for (int i = (bx * NTHREADS + tid); i < DEPTH * NB * 32; i += G * NTHREADS) hmax[i] = 0u;
        for (int m0 = gw; m0 < M; m0 += 4 * NGW) {
            f32x4 v[4][4];
#pragma unroll
            for (int q = 0; q < 4; ++q) { const int m = m0 + q * NGW; if (m < M) { const float* xr = (m < M_P) ? a.xp + (size_t)m * DM : a.xs + (size_t)(m - M_P) * DM; const f32x4* x4 = (const f32x4*)xr + lane;
#pragma unroll
                for (int j = 0; j < 4; ++j) v[q][j] = x4[64 * j]; } }
#pragma unroll
            for (int q = 0; q < 4; ++q) { const int m = m0 + q * NGW; if (m < M) { float s = 0.f;
#pragma unroll
                for (int j = 0; j < 4; ++j) s += (v[q][j].x * v[q][j].x + v[q][j].y * v[q][j].y) + (v[q][j].z * v[q][j].z + v[q][j].w * v[q][j].w);
                s = wave_sum(s);
                if (lane == 0) ssq[m] = (unsigned long long)(s * pg8::SSQ_SCALE);
                unsigned long long* o8 = (unsigned long long*)(XB + (size_t)m * DM) + lane;
#pragma unroll
                for (int j = 0; j < 4; ++j) o8[64 * j] = (unsigned long long)pk2(v[q][j].x, v[q][j].y) | ((unsigned long long)pk2(v[q][j].z, v[q][j].w) << 32); } }
        }
        if (bx == 0 && wave == 0) {
            for (int l = 0; l < DEPTH; ++l) { const float* lq = a.lambda_qk + l * 256;
                const float s1 = wave_sum(lq[lane] * lq[64 + lane]), s2 = wave_sum(lq[128 + lane] * lq[192 + lane]);
                const float li = 0.8f - 0.6f * expf(-0.3f * (float)l);
                if (lane == 0) { misc[2 * l] = expf(s1) - expf(s2) + li; misc[2 * l + 1] = li; } }
        }
    }
    grid.sync();

    for (int l = 0; l < DEPTH; ++l) {
        {
            pg8::Gemm g{XB, WinT + (size_t)l * DIN * DM, M, DIN, DM, DM, 0}; pg8::StaticOrder S; S.init(M, DIN, G, bx);
            pg8::EpiZ E{Z, ssq + (size_t)l * M, 0.125f * 1.4426950408889634f, hmax + l * NB * 32};
#ifndef NO_GEMM1
            pg8::gemm_phase<pg8::EpiZ, pg8::StaticOrder, true, true>(lds, g, S, E, wave);
#endif
#ifdef PROBE_GEMM1X2
            grid.sync();
#ifdef PROBE_SYNC2
        grid.sync(); grid.sync(); grid.sync(); grid.sync();
#endif
            pg8::gemm_phase<pg8::EpiZ, pg8::StaticOrder, true, true>(lds, g, S, E, wave);
#endif
        }
        grid.sync();
#ifdef PROBE_SYNC2
        grid.sync(); grid.sync(); grid.sync(); grid.sync();
#endif
        {
            const float lam = __uint_as_float(__builtin_amdgcn_readfirstlane(__float_as_uint(misc[2 * l]))), li = __uint_as_float(__builtin_amdgcn_readfirstlane(__float_as_uint(misc[2 * l + 1])));
            const unsigned* hmaxL = hmax + l * NB * 32;
            const int nper = G / 8, xcd = vcu / nper, slot = vcu % nper;
#ifndef NO_ATT
            const int nunits = (G == 256) ? 12 : (NB * 4 * 32 - bx + G - 1) / G;
            for (int i = 0; i < nunits; ++i) { int pair, qb, pairN, qbN;
                if (G == 256) { pair = i * 8 + ((xcd + i) & 7); qb = (slot + 11 * i) & 31; pairN = (i + 1) * 8 + ((xcd + i + 1) & 7); qbN = (slot + 11 * (i + 1)) & 31; }
                else { const int u = bx + i * G; pair = u >> 5; qb = u & 31; pairN = (u + G) >> 5; qbN = (u + G) & 31; }
                const int b = pair >> 2, h = pair & 3;
                const float slope2 = exp2f(-2.0f * (float)(h + 1)) * 1.4426950408889634f;
                int W; float Rg;
                { const unsigned* hp = hmaxL + b * 32 + h * 4; float R2 = 0.f;
                  for (int c = 0; c < 2; ++c) { const float q2 = __uint_as_float(__builtin_amdgcn_readfirstlane(hp[2 * c])) + __uint_as_float(__builtin_amdgcn_readfirstlane(hp[2 * c + 1]));
                      const float k2 = __uint_as_float(__builtin_amdgcn_readfirstlane(hp[16 + 2 * c])) + __uint_as_float(__builtin_amdgcn_readfirstlane(hp[16 + 2 * c + 1])); R2 = fmaxf(R2, q2 * k2); }
                  const float R = sqrtf(R2) * 1.02f + 0.5f; Rg = R; const float dd = (160.0f + 2.0f * R) / slope2;
                  const float wf = floorf((dd - 1.0f) * (1.0f / 64.0f)) + 1.0f; W = (wf >= 62.0f) ? 62 : (wf < 0.f ? 0 : (int)wf); }
                const bool track = !(Rg <= 48.0f);
                mix::attn_unit(lds, Z, b, h, qb, slope2, lam, 1.0f - li, a.subln_g + l * 128, wave, W, track, i == 0, i + 1 < nunits, pairN >> 2, pairN & 3, qbN); }
#endif
#ifndef NO_SGU
#ifdef PROBE_SGU2
            for (int u = bx; u < NB * 32; u += G)
                mix::sgu_unit(lds, Z, u >> 5, u & 31, a.vnorm_g + l * 512, Wsb + (size_t)l * 4 * 128 * 128, a.b_s + l * 512, wave, true);
#endif
            for (int u = bx; u < NB * 32; u += G)
                mix::sgu_unit(lds, Z, u >> 5, u & 31, a.vnorm_g + l * 512, Wsb + (size_t)l * 4 * 128 * 128, a.b_s + l * 512, wave);
#endif
        }
        grid.sync();
#ifdef PROBE_SYNC2
        grid.sync(); grid.sync(); grid.sync(); grid.sync();
#endif
        {
            pg8::Gemm g{Z, WoutT + (size_t)l * DM * DM, M, DM, DM, DIN, 3072}; pg8::StaticOrder S; S.init(M, DM, G, bx);
            pg8::EpiRes E{XB, ssq + (size_t)(l + 1) * M, false};
#ifdef PROBE_GEMM2X2
            { pg8::EpiRes E2 = E; E2.dry = true; pg8::gemm_phase<pg8::EpiRes, pg8::StaticOrder, true, true>(lds, g, S, E2, wave); grid.sync(); }
#endif
#ifndef NO_GEMM2
            pg8::gemm_phase<pg8::EpiRes, pg8::StaticOrder, true, true>(lds, g, S, E, wave);
#endif
        }
        grid.sync();
#ifdef PROBE_SYNC2
        grid.sync(); grid.sync(); grid.sync(); grid.sync();
#endif
    }
    {
        int lane_ = lane_now(); asm volatile("" : "+v"(lane_)); const int lane = lane_;
        const int gw = vcu * NWAVES + wave, NGW = G * NWAVES;
        const f32x4* g4 = (const f32x4*)a.final_g + lane; f32x4 gv[4];
#pragma unroll
        for (int j = 0; j < 4; ++j) gv[j] = g4[64 * j];
        for (int m0 = gw; m0 < M; m0 += 4 * NGW) {
            unsigned long long w[4][4]; unsigned long long sq[4];
#pragma unroll
            for (int q = 0; q < 4; ++q) { const int m = m0 + q * NGW; if (m < M) { sq[q] = ssq[(size_t)4 * M + m]; const unsigned long long* xr = (const unsigned long long*)(XB + (size_t)m * DM) + lane;
#pragma unroll
                for (int j = 0; j < 4; ++j) w[q][j] = xr[64 * j]; } }
#pragma unroll
            for (int q = 0; q < 4; ++q) { const int m = m0 + q * NGW; if (m < M) {
                const float rs = __builtin_amdgcn_rsqf((float)sq[q] * (pg8::SSQ_INV / 1024.0f) + 1e-6f);
                f32x4* o4 = (f32x4*)(a.out + (size_t)m * DM) + lane;
#pragma unroll
                for (int j = 0; j < 4; ++j) { const unsigned lo = (unsigned)w[q][j], hi = (unsigned)(w[q][j] >> 32);
                    f32x4 v = {__uint_as_float(lo << 16), __uint_as_float(lo & 0xffff0000u), __uint_as_float(hi << 16), __uint_as_float(hi & 0xffff0000u)};
                    o4[64 * j] = v * rs * gv[j]; } } }
        }
    }
}

extern "C" void kernel_launch(void* const* d_in, const int* in_sizes, int n_in, void* d_out, int out_size, void* d_ws, size_t ws_size, hipStream_t stream) {
    static int grid = 0;
    if (grid == 0) {
        if (n_in != 11 || in_sizes[0] != M_P * DM || out_size != M * DM || ws_size < WS_END) { fprintf(stderr, "kernel_launch: unexpected shapes (n_in %d in0 %d out %d ws %zu)\n", n_in, n_in > 0 ? in_sizes[0] : -1, out_size, ws_size); grid = -1; return; }
        int dev = 0, cus = 0, per_cu = 0;
        if (hipGetDevice(&dev) != hipSuccess || hipDeviceGetAttribute(&cus, hipDeviceAttributeMultiprocessorCount, dev) != hipSuccess) { grid = -1; return; }
        if (hipFuncSetAttribute((const void*)hymba_fwd, hipFuncAttributeMaxDynamicSharedMemorySize, LDS_BYTES) != hipSuccess) { fprintf(stderr, "kernel_launch: hipFuncSetAttribute failed\n"); grid = -1; return; }
        if (hipOccupancyMaxActiveBlocksPerMultiprocessor(&per_cu, (const void*)hymba_fwd, NTHREADS, LDS_BYTES) != hipSuccess || per_cu < 1) { fprintf(stderr, "kernel_launch: occupancy query says %d blocks per CU\n", per_cu); per_cu = 1; }
        (void)hipGetLastError();
        grid = cus;
    }
    if (grid < 0) return;
    Args a{};
    a.xp = (const float*)d_in[0]; a.xs = (const float*)d_in[1]; a.norm_g = (const float*)d_in[2]; a.w_in = (const float*)d_in[3]; a.lambda_qk = (const float*)d_in[4];
    a.subln_g = (const float*)d_in[5]; a.vnorm_g = (const float*)d_in[6]; a.w_s = (const float*)d_in[7]; a.b_s = (const float*)d_in[8]; a.w_out = (const float*)d_in[9]; a.final_g = (const float*)d_in[10];
    a.out = (float*)d_out; a.ws = (unsigned char*)d_ws;
    void* args[] = {&a};
    hipError_t e = hipLaunchCooperativeKernel((const void*)hymba_fwd, dim3(grid), dim3(NTHREADS), args, LDS_BYTES, stream);
    if (e != hipSuccess) fprintf(stderr, "kernel_launch: cooperative launch failed: %s (grid %d)\n", hipGetErrorString(e), grid);
}
```

```cpp
#include <hip/hip_runtime.h>
#include <hip/hip_bf16.h>
#include <hip/hip_cooperative_groups.h>
#include <cstdio>
#include <cstdint>
#include <cmath>
namespace cg = cooperative_groups;
__device__ __forceinline__ int lane_now() { unsigned z; asm volatile("s_mov_b32 %0, 0" : "=s"(z)); return (int)__builtin_amdgcn_mbcnt_hi(~0u, __builtin_amdgcn_mbcnt_lo(~0u, z)); }
namespace pg8 {
#define PG8_LAS __attribute__((address_space(3)))
typedef unsigned short bf16_t;
typedef short bf16x8 __attribute__((ext_vector_type(8)));
typedef float f32x4 __attribute__((ext_vector_type(4)));
typedef unsigned u32x4 __attribute__((ext_vector_type(4)));
constexpr int BM = 256, BK = 64, HALF = 128, HTB = HALF * BK * 2  , STAGE_BYTES = 8 * HTB, NXCD = 8, WGM = 8;

__host__ __device__ __forceinline__ int lds_byte(int r, int c) { const int st = (r >> 4) * 2 + (c >> 5), rr = r & 15, cc = c & 31, ob = rr * 64 + cc * 2; return st * 1024 + (ob ^ (((ob >> 9) & 1) << 5)); }
__host__ __device__ __forceinline__ void stage_rc(int b, int& R, int& C) { const int st = b / 1024, sb = b % 1024, swz = sb ^ (((sb >> 9) & 1) << 5); R = (st >> 1) * 16 + swz / 64; C = (st & 1) * 32 + (swz % 64) / 2; }
__host__ __device__ __forceinline__ int perm32(int rho) { const int n = rho >> 4, i = rho & 15; return 8 * (i >> 2) + 4 * n + (i & 3); }

struct Unit { int pm, pn; };
struct Gemm { const bf16_t* A; const bf16_t* Bt; int M, N, K, lda, kjump; };

struct StaticOrder {
    int nM, nN, nwg, G, c;
    __host__ __device__ void init(int M, int N, int G_, int c_) { nM = M / BM; nN = N / BM; nwg = nM * nN; G = G_; c = c_; }
    __host__ __device__ bool next(int i, Unit& u) const {
        const long L = (long)i * G + c; if (L >= nwg) return false;
        int wgid = (int)L; { const int q = nwg / NXCD, r = nwg % NXCD, xcd = wgid % NXCD, off = wgid / NXCD; wgid = (xcd < r ? xcd * (q + 1) : r * (q + 1) + (xcd - r) * q) + off; }
        const int nig = WGM * nN, gid = wgid / nig, fm = gid * WGM, gsz = (nM - fm) < WGM ? (nM - fm) : WGM;
        u.pm = fm + ((wgid % nig) % gsz); u.pn = (wgid % nig) / gsz; return true;
    }
    __device__ __forceinline__ void a_ready(const Unit&) const {}
    __device__ __forceinline__ void done(const Unit&) const {}
};

__device__ __forceinline__ unsigned cvt_pk_bf16(float lo, float hi) { unsigned r; asm volatile("v_cvt_pk_bf16_f32 %0, %1, %2" : "=v"(r) : "v"(lo), "v"(hi)); return r; }
constexpr int SSQ_SHIFT = 24;
constexpr float SSQ_SCALE = 16777216.0f, SSQ_INV = 1.0f / 16777216.0f;
struct EpiZ {
    static constexpr bool PERM = true, AFTER_DRAIN = false;
    bf16_t* Z; const unsigned long long* ssq; float c2; unsigned* hmax;
    __device__ __forceinline__ void operator()(const f32x4 (&acc)[2][2][4][2], const Unit& u, int wr, int wc, int fr, int fq) const {
        const int row0 = u.pm * BM + wr * 64 + fr; const int col0 = u.pn * BM + wc * 32 + 8 * fq;
        const float sc = (u.pn < 2) ? c2 : 1.0f;
        float hm0 = 0.f, hm1 = 0.f;
        unsigned long long sq[8];
#pragma unroll
        for (int i = 0; i < 8; ++i) sq[i] = ssq[row0 + (i >> 2) * HALF + (i & 3) * 16];
#pragma unroll
        for (int ai = 0; ai < 2; ++ai)
#pragma unroll
            for (int m = 0; m < 4; ++m) { const int row = row0 + ai * HALF + m * 16;
                const float ms = (float)sq[ai * 4 + m] * (SSQ_INV / 1024.0f);
                const float rs = __builtin_amdgcn_rsqf(ms + 1e-6f) * sc;
                bf16_t* rowp = Z + (size_t)row * 3584 + col0;
#pragma unroll
                for (int bj = 0; bj < 2; ++bj) { const f32x4 v0 = acc[ai][bj][m][0] * rs, v1 = acc[ai][bj][m][1] * rs;
                    u32x4 w; w.x = cvt_pk_bf16(v0[0], v0[1]); w.y = cvt_pk_bf16(v0[2], v0[3]); w.z = cvt_pk_bf16(v1[0], v1[1]); w.w = cvt_pk_bf16(v1[2], v1[3]);
                    *(u32x4*)(rowp + bj * HALF) = w;
                    if (u.pn < 4) { float q = (v0[0] * v0[0] + v0[1] * v0[1]) + (v0[2] * v0[2] + v0[3] * v0[3]) + (v1[0] * v1[0] + v1[1] * v1[1]) + (v1[2] * v1[2] + v1[3] * v1[3]);
                        q += __shfl_xor(q, 16); q += __shfl_xor(q, 32); if (bj == 0) hm0 = __builtin_fmaxf(hm0, q); else hm1 = __builtin_fmaxf(hm1, q); } } }
        if (u.pn < 4) {
#pragma unroll
            for (int o = 1; o < 16; o <<= 1) { hm0 = __builtin_fmaxf(hm0, __shfl_xor(hm0, o)); hm1 = __builtin_fmaxf(hm1, __shfl_xor(hm1, o)); }
            if (fr == 0 && fq == 0) { unsigned* hp = hmax + (u.pm >> 4) * 32 + u.pn * 8 + wc; atomicMax(hp, __float_as_uint(hm0)); atomicMax(hp + 4, __float_as_uint(hm1)); } }
    }
};
struct EpiRes {
    static constexpr bool PERM = true, AFTER_DRAIN = false;
    bf16_t* xb; unsigned long long* ssqn; bool dry;
    __device__ __forceinline__ void operator()(const f32x4 (&acc)[2][2][4][2], const Unit& u, int wr, int wc, int fr, int fq) const {
        const int row0 = u.pm * BM + wr * 64 + fr; const int col0 = u.pn * BM + wc * 32 + 8 * fq;
        u32x4 pre[2][4][2];
#pragma unroll
        for (int ai = 0; ai < 2; ++ai)
#pragma unroll
            for (int m = 0; m < 4; ++m)
#pragma unroll
                for (int bj = 0; bj < 2; ++bj) pre[ai][m][bj] = *(const u32x4*)(xb + (size_t)(row0 + ai * HALF + m * 16) * 1024 + col0 + bj * HALF);
#pragma unroll
        for (int ai = 0; ai < 2; ++ai)
#pragma unroll
            for (int m = 0; m < 4; ++m) { const int row = row0 + ai * HALF + m * 16; const size_t off = (size_t)row * 1024 + col0; float ss = 0.f;
#pragma unroll
                for (int bj = 0; bj < 2; ++bj) { const u32x4 bw = pre[ai][m][bj];
                    const f32x4 b0 = {__uint_as_float(bw.x << 16), __uint_as_float(bw.x & 0xffff0000u), __uint_as_float(bw.y << 16), __uint_as_float(bw.y & 0xffff0000u)};
                    const f32x4 b1 = {__uint_as_float(bw.z << 16), __uint_as_float(bw.z & 0xffff0000u), __uint_as_float(bw.w << 16), __uint_as_float(bw.w & 0xffff0000u)};
                    const f32x4 v0 = acc[ai][bj][m][0] + b0, v1 = acc[ai][bj][m][1] + b1;
                    u32x4 w; w.x = cvt_pk_bf16(v0[0], v0[1]); w.y = cvt_pk_bf16(v0[2], v0[3]); w.z = cvt_pk_bf16(v1[0], v1[1]); w.w = cvt_pk_bf16(v1[2], v1[3]);
                    if (!dry) *(u32x4*)(xb + off + bj * HALF) = w;
                    ss += (v0[0] * v0[0] + v0[1] * v0[1]) + (v0[2] * v0[2] + v0[3] * v0[3]) + (v1[0] * v1[0] + v1[1] * v1[1]) + (v1[2] * v1[2] + v1[3] * v1[3]); }
                ss += __shfl_xor(ss, 16); ss += __shfl_xor(ss, 32);
                if (fq == 0 && (!dry || ss < 0.f)) atomicAdd(ssqn + row, (unsigned long long)(ss * SSQ_SCALE)); }
    }
};
template <class Epi, class Sched, bool ALIGN_EPI = false, bool SP2 = false>
__device__ __forceinline__ void gemm_phase(PG8_LAS unsigned char* lds, const Gemm g, const Sched& S, const Epi& E, const int wave_in) {
    int tid_ = wave_in * 64 + lane_now(); asm volatile("" : "+v"(tid_));
    const int tid = tid_, wid = __builtin_amdgcn_readfirstlane(tid >> 6), lane = tid & 63, wr = wid >> 2, wc = wid & 3, fr = lane & 15, fq = lane >> 4;
    const int K = g.K, nt = K / BK;
    unsigned voffA[2], voffB[2];
#pragma unroll
    for (int i = 0; i < 2; ++i) { int R, C; stage_rc(tid * 16 + i * 8192, R, C); const int Rb = Epi::PERM ? ((R & ~31) + perm32(R & 31)) : R;
        voffA[i] = (unsigned)(R * g.lda + C) * 2u; voffB[i] = (unsigned)(Rb * K + C) * 2u; }
    const size_t kstep = (size_t)(BK * 2);
    const size_t hstepA = (size_t)HALF * g.lda * 2, hstepB = (size_t)HALF * K * 2;
    const size_t tstepA = 2 * hstepA, tstepB = 2 * hstepB;
    const size_t kjump = (size_t)g.kjump;
#define PG8_KOFFA(t) ((size_t)(t) * kstep + ((t) >= 8 ? kjump : (size_t)0))
    const unsigned ldsw = (unsigned)wid * 1024u;
    const int aoff = lds_byte(wr * 64 + fr, fq * 8), boff = lds_byte(wc * 32 + fr, fq * 8);
#define PG8_SA(b, h) (((b) * 2 + (h)) * HTB)
#define PG8_SB(b, h) ((4 + (b) * 2 + (h)) * HTB)
#define PG8_STAGE(bufoff, gbase, voff) do { _Pragma("unroll") for (int _i = 0; _i < 2; ++_i) \
        __builtin_amdgcn_global_load_lds((const unsigned*)((const char*)(gbase) + (voff)[_i]), (PG8_LAS unsigned*)(lds + (bufoff) + ldsw + _i * 8192), 16, 0, 0); } while (0)
#define PG8_LDA(dst, b, h) do { _Pragma("unroll") for (int m = 0; m < 4; ++m) _Pragma("unroll") for (int k = 0; k < 2; ++k) dst[m][k] = *(const PG8_LAS bf16x8*)(lds + PG8_SA(b, h) + aoff + m * 2048 + k * 1024); } while (0)
#define PG8_LDB(dst, b, h) do { _Pragma("unroll") for (int n = 0; n < 2; ++n) _Pragma("unroll") for (int k = 0; k < 2; ++k) dst[n][k] = *(const PG8_LAS bf16x8*)(lds + PG8_SB(b, h) + boff + n * 2048 + k * 1024); } while (0)
#define PG8_MMA(ai, bj, At, Bt) do { __builtin_amdgcn_s_setprio(1); _Pragma("unroll") for (int m = 0; m < 4; ++m) _Pragma("unroll") for (int n = 0; n < 2; ++n) _Pragma("unroll") for (int k = 0; k < 2; ++k) \
        acc[ai][bj][m][n] = __builtin_amdgcn_mfma_f32_16x16x32_bf16(Bt[n][k], At[m][k], acc[ai][bj][m][n], 0, 0, 0); __builtin_amdgcn_s_setprio(0); } while (0)
#define PG8_WAIT_V(n) asm volatile("s_waitcnt vmcnt(" #n ")" ::: "memory")
#define PG8_WAIT_L(n) asm volatile("s_waitcnt lgkmcnt(" #n ")" ::: "memory")
#define PG8_BAR __builtin_amdgcn_s_barrier()
#define PG8_SCHED __builtin_amdgcn_sched_barrier(0)
    Unit cur, nxt; int ui = 0;
    if (!S.next(0, cur)) return;
    f32x4 acc[2][2][4][2];
#pragma unroll
    for (int a = 0; a < 2; ++a)
#pragma unroll
        for (int b = 0; b < 2; ++b)
#pragma unroll
            for (int m = 0; m < 4; ++m)
#pragma unroll
                for (int n = 0; n < 2; ++n) acc[a][b][m][n] = (f32x4){0.f, 0.f, 0.f, 0.f};
    bf16x8 At[4][2], B0[2][2], B1[2][2];
    const char* cA = (const char*)g.A + (size_t)cur.pm * tstepA; const char* cB = (const char*)g.Bt + (size_t)cur.pn * tstepB;
    S.a_ready(cur);
    if constexpr (SP2) {
        PG8_STAGE(PG8_SB(0, 0), cB, voffB); PG8_STAGE(PG8_SB(0, 1), cB + hstepB, voffB); PG8_STAGE(PG8_SA(0, 0), cA, voffA); PG8_STAGE(PG8_SA(0, 1), cA + hstepA, voffA);
        if (wr == 1) PG8_BAR;
        PG8_WAIT_V(2); PG8_BAR;
        PG8_STAGE(PG8_SB(1, 0), cB + kstep, voffB); PG8_STAGE(PG8_SA(1, 0), cA + kstep, voffA); PG8_STAGE(PG8_SB(1, 1), cB + hstepB + kstep, voffB);
        PG8_WAIT_V(6); PG8_BAR;
    } else {
        PG8_STAGE(PG8_SB(0, 0), cB, voffB); PG8_STAGE(PG8_SA(0, 0), cA, voffA); PG8_STAGE(PG8_SB(0, 1), cB + hstepB, voffB); PG8_STAGE(PG8_SA(0, 1), cA + hstepA, voffA);
        if (wr == 1) PG8_BAR;
        PG8_WAIT_V(4); PG8_BAR;
        PG8_STAGE(PG8_SB(1, 0), cB + kstep, voffB); PG8_STAGE(PG8_SA(1, 0), cA + kstep, voffA); PG8_STAGE(PG8_SB(1, 1), cB + hstepB + kstep, voffB);
        PG8_WAIT_V(6); PG8_BAR;
    }
    for (;;) {
        const bool has_next = S.next(ui + 1, nxt);
        const char* nA = has_next ? (const char*)g.A + (size_t)nxt.pm * tstepA : cA; const char* nB = has_next ? (const char*)g.Bt + (size_t)nxt.pn * tstepB : cB;
        for (int t = 0; t < nt; t += 2) {
            const bool last = (t == nt - 2);
            const char* a1 = cA + PG8_KOFFA(t + 1);
            const char* a2 = last ? nA : cA + PG8_KOFFA(t + 2); const char* b2 = last ? nB : cB + (size_t)(t + 2) * kstep;
            const char* a3 = a2 + kstep; const char* b3 = b2 + kstep;
            if (last && has_next) S.a_ready(nxt);
            if constexpr (SP2) {
            PG8_LDB(B0, 0, 0); PG8_LDB(B1, 0, 1); PG8_SCHED; PG8_LDA(At, 0, 0); PG8_STAGE(PG8_SA(1, 1), a1 + hstepA, voffA);
            PG8_WAIT_V(8); PG8_WAIT_L(0); PG8_BAR; PG8_MMA(0, 0, At, B0); PG8_MMA(0, 1, At, B1); PG8_BAR; PG8_SCHED;
            PG8_LDA(At, 0, 1); PG8_STAGE(PG8_SB(0, 0), b2, voffB); PG8_STAGE(PG8_SB(0, 1), b2 + hstepB, voffB); PG8_STAGE(PG8_SA(0, 0), a2, voffA);
            PG8_WAIT_V(8); PG8_WAIT_L(0); PG8_BAR; PG8_MMA(1, 0, At, B0); PG8_MMA(1, 1, At, B1); PG8_BAR; PG8_SCHED;
            PG8_LDB(B0, 1, 0); PG8_LDB(B1, 1, 1); PG8_SCHED; PG8_LDA(At, 1, 0); PG8_STAGE(PG8_SA(0, 1), a2 + hstepA, voffA);
            PG8_WAIT_V(8); PG8_WAIT_L(0); PG8_BAR; PG8_MMA(0, 0, At, B0); PG8_MMA(0, 1, At, B1); PG8_BAR; PG8_SCHED;
            PG8_LDA(At, 1, 1); PG8_STAGE(PG8_SB(1, 0), b3, voffB); PG8_STAGE(PG8_SB(1, 1), b3 + hstepB, voffB); PG8_STAGE(PG8_SA(1, 0), a3, voffA);
            PG8_WAIT_V(8); PG8_WAIT_L(0); PG8_BAR; PG8_MMA(1, 0, At, B0); PG8_MMA(1, 1, At, B1); PG8_BAR; PG8_SCHED;
            } else {
            PG8_LDB(B0, 0, 0); PG8_SCHED; PG8_LDA(At, 0, 0); PG8_STAGE(PG8_SA(1, 1), a1 + hstepA, voffA);
            PG8_WAIT_L(8); PG8_BAR; PG8_WAIT_L(0); PG8_MMA(0, 0, At, B0); PG8_BAR; PG8_SCHED;
            PG8_LDB(B1, 0, 1); PG8_STAGE(PG8_SB(0, 0), b2, voffB);
            PG8_BAR; PG8_WAIT_L(0); PG8_MMA(0, 1, At, B1); PG8_BAR;
            PG8_LDA(At, 0, 1); PG8_STAGE(PG8_SA(0, 0), a2, voffA);
            PG8_BAR; PG8_WAIT_L(0); PG8_MMA(1, 0, At, B0); PG8_BAR; PG8_SCHED;
            PG8_STAGE(PG8_SB(0, 1), b2 + hstepB, voffB);
            PG8_WAIT_V(6); PG8_BAR; PG8_MMA(1, 1, At, B1); PG8_BAR;
            PG8_LDB(B0, 1, 0); PG8_SCHED; PG8_LDA(At, 1, 0); PG8_STAGE(PG8_SA(0, 1), a2 + hstepA, voffA);
            PG8_WAIT_L(8); PG8_BAR; PG8_WAIT_L(0); PG8_MMA(0, 0, At, B0); PG8_BAR; PG8_SCHED;
            PG8_LDB(B1, 1, 1); PG8_STAGE(PG8_SB(1, 0), b3, voffB);
            PG8_BAR; PG8_WAIT_L(0); PG8_MMA(0, 1, At, B1); PG8_BAR;
            PG8_LDA(At, 1, 1); PG8_STAGE(PG8_SA(1, 0), a3, voffA);
            PG8_BAR; PG8_WAIT_L(0); PG8_MMA(1, 0, At, B0); PG8_BAR; PG8_SCHED;
            PG8_STAGE(PG8_SB(1, 1), b3 + hstepB, voffB);
            PG8_WAIT_V(6); PG8_BAR; PG8_MMA(1, 1, At, B1); PG8_BAR;
            }
        }
        if constexpr (ALIGN_EPI) { if (wr == 0) PG8_BAR; }
        if constexpr (!Epi::AFTER_DRAIN) { E(acc, cur, wr, wc, fr, fq); S.done(cur); }
        if (!has_next) break;
#pragma unroll
        for (int a = 0; a < 2; ++a)
#pragma unroll
            for (int b = 0; b < 2; ++b)
#pragma unroll
                for (int m = 0; m < 4; ++m)
#pragma unroll
                    for (int n = 0; n < 2; ++n) acc[a][b][m][n] = (f32x4){0.f, 0.f, 0.f, 0.f};
        cur = nxt; cA = nA; cB = nB; ++ui;
        if constexpr (ALIGN_EPI) { if (wr == 1) PG8_BAR; }
    }
    PG8_WAIT_V(0);
    if constexpr (!ALIGN_EPI) { if (wr == 0) PG8_BAR; }
    PG8_BAR;
    if constexpr (Epi::AFTER_DRAIN) { E.fused(acc, cur, wr, wc, fr, fq, lds, wid, lane); S.done(cur); }
#undef PG8_KOFFA
#undef PG8_SA
#undef PG8_SB
#undef PG8_STAGE
#undef PG8_LDA
#undef PG8_LDB
#undef PG8_MMA
#undef PG8_WAIT_V
#undef PG8_WAIT_L
#undef PG8_BAR
#undef PG8_SCHED
}
}
namespace mix {
#define LAS __attribute__((address_space(3)))
typedef unsigned short bf16_t;
typedef short bf16x8 __attribute__((ext_vector_type(8)));
typedef short s16x4 __attribute__((ext_vector_type(4)));
typedef short v4i16_t __attribute__((ext_vector_type(4)));
typedef float f32x16 __attribute__((ext_vector_type(16)));
typedef float f32x4 __attribute__((ext_vector_type(4)));
typedef unsigned u32x4 __attribute__((ext_vector_type(4)));
typedef unsigned u32x2 __attribute__((ext_vector_type(2)));
typedef float f32x2_t __attribute__((ext_vector_type(2))); typedef __bf16 bf16x2_t __attribute__((ext_vector_type(2)));
constexpr int ZP = 3584, SEQ = 4096;
constexpr int KBUF = 32768;
constexpr int EXP = 132;
constexpr int QF_OFF = 98304;
constexpr int WSF_OFF = 131072;
constexpr float LOG2E = 1.4426950408889634f;
__device__ __forceinline__ int crow(int r, int hi) { return (r & 3) + 8 * (r >> 2) + 4 * hi; }
__device__ __forceinline__ unsigned cvtpk(float lo, float hi) { f32x2_t v = {lo, hi}; bf16x2_t b = __builtin_convertvector(v, bf16x2_t); return __builtin_bit_cast(unsigned, b); }
__device__ __forceinline__ float bf2f(unsigned short b) { return __uint_as_float((unsigned)b << 16); }
__device__ __forceinline__ float bflo(unsigned w) { return __uint_as_float(w << 16); }
__device__ __forceinline__ float bfhi(unsigned w) { return __uint_as_float(w & 0xffff0000u); }
__device__ __forceinline__ s16x4 vtr(const LAS unsigned char* p) { return __builtin_bit_cast(s16x4, __builtin_amdgcn_ds_read_tr16_b64_v4i16((LAS v4i16_t*)p)); }
__device__ __forceinline__ float swap32(float v) { auto rr = __builtin_amdgcn_permlane32_swap(__float_as_uint(v), __float_as_uint(v), false, false); return (__builtin_amdgcn_mbcnt_lo(~0u, 0u) & 32) ? __uint_as_float(rr[0]) : __uint_as_float(rr[1]); }
__device__ __forceinline__ float silu(float x) { return x * __builtin_amdgcn_rcpf(1.0f + __builtin_amdgcn_exp2f(-x * LOG2E)); }
__device__ __forceinline__ unsigned vtr_off(int lane, int cc, int t) {
    const int hi = lane >> 5, blk = (lane >> 4) & 1, q4 = (lane & 15) >> 2, p = lane & 3;
    return 256u * (4 * hi + 8 * t + q4) + 16u * (((cc ^ q4) << 2) | ((2 * blk + (p >> 1)) ^ (hi + 2 * t))) + 8u * (p & 1);
}
__device__ __forceinline__ void glds16(const void* gsrc, unsigned lds_dst) {
    asm volatile("s_mov_b32 m0, %1\n\ts_nop 0\n\tglobal_load_lds_dwordx4 %0, off" :: "v"(gsrc), "s"(lds_dst) : "memory", "m0"); }
__device__ __forceinline__ unsigned vst_off(int row, int ch) { return 256u * row + 16u * (ch ^ (((row & 3) << 2) | ((row >> 2) & 3))); }

__device__ __forceinline__ int att_tile(int i, int d0, int nl) { const int j = i - 2; const int tl = d0 - 1 - j, tr = d0 + i - nl; int t = (j < nl) ? tl : tr; t = (i < 2) ? d0 + i : t; return t; }
__device__ __forceinline__ void attn_unit(LAS unsigned char* lds, bf16_t* Z, int b, int h, int qb, float slope2, float lam, float oml, const float* subg, const int wave_in, const int W, const bool track, const bool first, const bool has_next, const int bN, const int hN, const int qbN, bool dry = false) {
    int tid_ = wave_in * 64 + lane_now(); asm volatile("" : "+v"(tid_));
    const int tid = tid_, lane = tid & 63, r32 = lane & 31, hi = lane >> 5; const int wid = __builtin_amdgcn_readfirstlane(tid >> 6);
    const int c = wid >> 2, qs = wid & 3;
    const size_t rowbase = (size_t)b * SEQ;
    bf16x8 qf[4];
    { const bf16_t* Qw = Z + (rowbase + qb * 128 + qs * 32 + r32) * ZP + h * 128 + c * 64 + hi * 8;
#pragma unroll
      for (int s = 0; s < 4; ++s) qf[s] = *(const bf16x8*)(Qw + s * 16); }
    const int vrow0 = 8 * wid + (lane >> 4), vrow1 = vrow0 + 4;
    const bf16_t* vg0 = Z + (rowbase + vrow0) * ZP + 1024 + h * 128 + ((lane & 15) ^ (((vrow0 & 3) << 2) | ((vrow0 >> 2) & 3))) * 8;
    const bf16_t* vg1 = Z + (rowbase + vrow1) * ZP + 1024 + h * 128 + ((lane & 15) ^ (((vrow1 & 3) << 2) | ((vrow1 >> 2) & 3))) * 8;
    const bf16_t* kg0 = vg0 - 512; const bf16_t* kg1 = vg1 - 512;
    unsigned kaddr[4], vaddr[4][2];
#pragma unroll
    for (int s = 0; s < 4; ++s) kaddr[s] = vst_off(r32, c * 8 + 2 * s + hi);
#pragma unroll
    for (int cc = 0; cc < 4; ++cc) { vaddr[cc][0] = 49152u + vtr_off(lane, cc, 0); vaddr[cc][1] = 49152u + vtr_off(lane, cc, 1); }
    LAS float* wsf = (LAS float*)(lds + WSF_OFF) + wid * 64;
    const unsigned lds0 = (unsigned)(uintptr_t)lds;
    const int q0w = qb * 128 + qs * 32, qpos = q0w + r32;
    bf16x8 kaug[2];
    { u32x4 w; w.y = hi ? 0x00003F80u : 0u; w.z = 0u; w.w = 0u;
      const unsigned k0b = __float_as_uint((float)r32) >> 16, k1b = __float_as_uint((float)(32 + r32)) >> 16;
      w.x = hi ? 0x3F803F80u : (k0b | (k0b << 16)); kaug[0] = __builtin_bit_cast(bf16x8, w);
      w.x = hi ? 0x3F803F80u : (k1b | (k1b << 16)); kaug[1] = __builtin_bit_cast(bf16x8, w); }
    unsigned slw;
    { const unsigned sh = cvtpk(slope2, 0.f) & 0xffffu; const float shf = __uint_as_float(sh << 16); const unsigned sl = cvtpk(slope2 - shf, 0.f) & 0xffffu; slw = sh | (sl << 16); }
    float lsum = 0.f;
    const int d0 = 2 * qb;
    float mhat = 0.f; f32x16 o[4]; const f32x16 zero16 = f32x16{};
#pragma unroll
    for (int cc = 0; cc < 4; ++cc) o[cc] = f32x16{};
    const int nl = (d0 < W) ? d0 : W, nr = (62 - d0 < W) ? 62 - d0 : W, NT = 2 + nl + nr;
#define ATT_TILE(i) att_tile((i), d0, nl)
#define ATT_DMAK_(k0p, k1p, tile, slot) do { const size_t go = (size_t)(tile) * 64 * ZP; const unsigned bb = lds0 + (slot) * 16384 + wid * 2048; \
        glds16((k0p) + go, (unsigned)__builtin_amdgcn_readfirstlane(bb)); glds16((k1p) + go, (unsigned)__builtin_amdgcn_readfirstlane(bb + 1024)); } while (0)
#define ATT_DMAK(tile, slot) ATT_DMAK_(kg0, kg1, tile, slot)
#define ATT_DMAV_(v0p, v1p, tile, slot) do { const size_t go = (size_t)(tile) * 64 * ZP; const unsigned bb = lds0 + 49152 + (slot) * 16384 + wid * 2048; \
        glds16((v0p) + go, (unsigned)__builtin_amdgcn_readfirstlane(bb)); glds16((v1p) + go, (unsigned)__builtin_amdgcn_readfirstlane(bb + 1024)); } while (0)
#define ATT_DMAV(tile, slot) ATT_DMAV_(vg0, vg1, tile, slot)
#define ATT_BAR() do { asm volatile("s_waitcnt vmcnt(0)" ::: "memory"); __syncthreads(); } while (0)
#define ATT_BAR4() do { asm volatile("s_waitcnt vmcnt(4)" ::: "memory"); __syncthreads(); } while (0)
#define MX3(a, b, c) __builtin_fmaxf(__builtin_fmaxf((a), (b)), (c))
#define ATT_QAUG(dst, kvs) do { const float sg_ = ((kvs) <= q0w) ? 1.0f : -1.0f; const float x_ = __builtin_fmaf(sg_ * slope2, (float)((tile_) * 64 - qpos), -mhat); \
        const unsigned wa_ = cvtpk(x_, x_); const float r1_ = x_ - __uint_as_float(wa_ & 0xffff0000u); const unsigned wb_ = cvtpk(r1_, r1_); const float r2_ = r1_ - __uint_as_float(wb_ & 0xffff0000u); \
        const unsigned wc_ = cvtpk(r2_, 0.f); u32x4 w_; w_.x = hi ? ((wa_ & 0xffffu) | (wb_ & 0xffff0000u)) : (((kvs) <= q0w) ? slw : (slw ^ 0x80008000u)); w_.y = hi ? wc_ : 0u; w_.z = 0u; w_.w = 0u; dst = __builtin_bit_cast(bf16x8, w_); } while (0)
#define ATT_QK(tile, kslot) do { const int tile_ = (tile); const LAS unsigned char* kb_ = lds + (kslot) * 16384; bf16x8 kf_[8]; \
        _Pragma("unroll") for (int s = 0; s < 4; ++s) { kf_[2 * s] = *(const LAS bf16x8*)(kb_ + kaddr[s]); kf_[2 * s + 1] = *(const LAS bf16x8*)(kb_ + kaddr[s] + 8192); } \
        bf16x8 qa0_, qa1_; ATT_QAUG(qa0_, tile_ * 64); ATT_QAUG(qa1_, tile_ * 64 + 32); \
        s0 = __builtin_amdgcn_mfma_f32_32x32x16_bf16(kaug[0], qa0_, zero16, 0, 0, 0); s1 = __builtin_amdgcn_mfma_f32_32x32x16_bf16(kaug[1], qa1_, zero16, 0, 0, 0); \
        _Pragma("unroll") for (int s = 0; s < 4; ++s) { s0 = __builtin_amdgcn_mfma_f32_32x32x16_bf16(kf_[2 * s], qf[s], s0, 0, 0, 0); s1 = __builtin_amdgcn_mfma_f32_32x32x16_bf16(kf_[2 * s + 1], qf[s], s1, 0, 0, 0); } \
        if (tile_ == d0 + (qs >> 1)) { const float m2_ = -2.0f * slope2; \
            if (qs & 1) { _Pragma("unroll") for (int r = 0; r < 16; ++r) s1[r] = __builtin_fmaf(m2_, __builtin_fmaxf((float)(crow(r, hi) - r32), 0.f), s1[r]); } \
            else { _Pragma("unroll") for (int r = 0; r < 16; ++r) s0[r] = __builtin_fmaf(m2_, __builtin_fmaxf((float)(crow(r, hi) - r32), 0.f), s0[r]); } } } while (0)
#define ATT_QK_OFF(tile, kslot) do { const int tile_ = (tile); const LAS unsigned char* kb_ = lds + (kslot) * 16384; bf16x8 kf_[8]; \
        _Pragma("unroll") for (int s = 0; s < 4; ++s) { kf_[2 * s] = *(const LAS bf16x8*)(kb_ + kaddr[s]); kf_[2 * s + 1] = *(const LAS bf16x8*)(kb_ + kaddr[s] + 8192); } \
        bf16x8 qa0_; ATT_QAUG(qa0_, tile_ * 64); \
        s0 = __builtin_amdgcn_mfma_f32_32x32x16_bf16(kaug[0], qa0_, zero16, 0, 0, 0); s1 = __builtin_amdgcn_mfma_f32_32x32x16_bf16(kaug[1], qa0_, zero16, 0, 0, 0); \
        _Pragma("unroll") for (int s = 0; s < 4; ++s) { s0 = __builtin_amdgcn_mfma_f32_32x32x16_bf16(kf_[2 * s], qf[s], s0, 0, 0, 0); s1 = __builtin_amdgcn_mfma_f32_32x32x16_bf16(kf_[2 * s + 1], qf[s], s1, 0, 0, 0); } } while (0)
#define ATT_ROWMAX(rm) do { float a_ = MX3(s0[0], s0[1], s1[0]), b_ = MX3(s0[2], s0[3], s1[1]); a_ = MX3(a_, s1[2], s1[3]); \
        _Pragma("unroll") for (int r = 4; r < 16; r += 4) { a_ = MX3(a_, s0[r], s0[r + 1]); b_ = MX3(b_, s0[r + 2], s0[r + 3]); a_ = MX3(a_, s1[r], s1[r + 1]); b_ = MX3(b_, s1[r + 2], s1[r + 3]); } \
        rm = __builtin_fmaxf(a_, b_); rm = __builtin_fmaxf(rm, swap32(rm)); } while (0)
#define ATT_RESC_CHECK(rm) do { if (__any(rm > 8.0f)) { const float dl = __builtin_fmaxf(rm, 0.f); mhat += dl; \
        _Pragma("unroll") for (int r = 0; r < 16; ++r) { s0[r] -= dl; s1[r] -= dl; } \
        const float f = __builtin_amdgcn_exp2f(-dl); lsum *= f; wsf[r32] = f; resc = true; } } while (0)
#define ATT_EXP_PACK() do { float sa_ = 0.f, sb_ = 0.f; \
        _Pragma("unroll") for (int r = 0; r < 16; ++r) { s0[r] = __builtin_amdgcn_exp2f(s0[r]); s1[r] = __builtin_amdgcn_exp2f(s1[r]); sa_ += s0[r]; sb_ += s1[r]; } \
        lsum += sa_ + sb_; u32x4 w; \
        w.x = cvtpk(s0[0], s0[1]); w.y = cvtpk(s0[2], s0[3]); w.z = cvtpk(s0[4], s0[5]); w.w = cvtpk(s0[6], s0[7]); pf[0] = __builtin_bit_cast(bf16x8, w); \
        w.x = cvtpk(s0[8], s0[9]); w.y = cvtpk(s0[10], s0[11]); w.z = cvtpk(s0[12], s0[13]); w.w = cvtpk(s0[14], s0[15]); pf[1] = __builtin_bit_cast(bf16x8, w); \
        w.x = cvtpk(s1[0], s1[1]); w.y = cvtpk(s1[2], s1[3]); w.z = cvtpk(s1[4], s1[5]); w.w = cvtpk(s1[6], s1[7]); pf[2] = __builtin_bit_cast(bf16x8, w); \
        w.x = cvtpk(s1[8], s1[9]); w.y = cvtpk(s1[10], s1[11]); w.z = cvtpk(s1[12], s1[13]); w.w = cvtpk(s1[14], s1[15]); pf[3] = __builtin_bit_cast(bf16x8, w); } while (0)
#define ATT_RESC_APPLY() do { if (resc) { asm volatile("s_waitcnt lgkmcnt(0)" ::: "memory"); __builtin_amdgcn_wave_barrier(); \
        _Pragma("unroll") for (int k = 0; k < 4; ++k) { const f32x4 fv_ = *(const LAS f32x4*)(wsf + 8 * k + 4 * hi); \
            _Pragma("unroll") for (int cc = 0; cc < 4; ++cc) { o[cc][4 * k + 0] *= fv_[0]; o[cc][4 * k + 1] *= fv_[1]; o[cc][4 * k + 2] *= fv_[2]; o[cc][4 * k + 3] *= fv_[3]; } \
            } \
        asm volatile("s_waitcnt lgkmcnt(0)" ::: "memory"); __builtin_amdgcn_wave_barrier(); } } while (0)
#define ATT_VRD(dst, vb_, cc) do { _Pragma("unroll") for (int ks = 0; ks < 4; ++ks) { dst[2 * ks] = vtr(vb_ + vaddr[cc][0] + ks * 4096); dst[2 * ks + 1] = vtr(vb_ + vaddr[cc][1] + ks * 4096); } } while (0)
#define ATT_VF(src, ks) (bf16x8){src[2 * (ks)][0], src[2 * (ks)][1], src[2 * (ks)][2], src[2 * (ks)][3], src[2 * (ks) + 1][0], src[2 * (ks) + 1][1], src[2 * (ks) + 1][2], src[2 * (ks) + 1][3]}
#define ATT_PV(cc, src) do { _Pragma("unroll") for (int ks = 0; ks < 4; ++ks) o[cc] = __builtin_amdgcn_mfma_f32_32x32x16_bf16(pf[ks], ATT_VF(src, ks), o[cc], 0, 0, 0); } while (0)
    f32x16 s0, s1; bf16x8 pf[4]; bool resc = false;
    f32x4 fv[4];
    if (c == 0) __builtin_amdgcn_s_setprio(1);
    {
        if (first) { ATT_DMAK(ATT_TILE(0), 0); ATT_DMAV(ATT_TILE(0), 0); ATT_DMAK(ATT_TILE(1), 1); }
        { const int i2 = (2 < NT) ? 2 : NT - 1; const int t2 = ATT_TILE(i2); ATT_DMAK(t2, 2); ATT_DMAV(ATT_TILE(1), 1); } }
    ATT_BAR4();
    { ATT_QK(ATT_TILE(0), 0); if (track) { float rm; ATT_ROWMAX(rm); ATT_RESC_CHECK(rm); } ATT_EXP_PACK(); resc = false; }
    ATT_BAR();
#define ATT_PVC(cc, src) do { _Pragma("unroll") for (int ks = 0; ks < 4; ++ks) o[cc] = __builtin_amdgcn_mfma_f32_32x32x16_bf16(pc[ks], ATT_VF(src, ks), o[cc], 0, 0, 0); } while (0)
#define ATT_LSUM() do { } while (0)
    int m3 = 0;
    {
        const int i = 0;
        const int m3p1 = (m3 == 2) ? 0 : m3 + 1, m3p2 = (m3 == 0) ? 2 : m3 - 1;
        { const int i3 = __builtin_elementwise_min(i + 3, NT - 1); const int t3 = ATT_TILE(i3); ATT_DMAK(t3, m3); }
        { const int i2 = __builtin_elementwise_min(i + 2, NT - 1); const int t2 = ATT_TILE(i2); ATT_DMAV(t2, m3p2); }
        const int t1 = ATT_TILE(i + 1);
        const LAS unsigned char* vb = lds + m3 * 16384;
        s16x4 va[8], vbb[8];
        bf16x8 pc[4];
#pragma unroll
        for (int k = 0; k < 4; ++k) pc[k] = pf[k];
        ATT_VRD(va, vb, 0);
        ATT_QK(t1, m3p1);
        ATT_VRD(vbb, vb, 1);
        if (track) { float rm; ATT_ROWMAX(rm); ATT_RESC_CHECK(rm); }
        ATT_PVC(0, va);
        ATT_VRD(va, vb, 2);
        ATT_PVC(1, vbb);
        ATT_VRD(vbb, vb, 3);
        ATT_EXP_PACK();
        ATT_PVC(2, va);
        ATT_LSUM();
        ATT_PVC(3, vbb);
        asm volatile("" : "+v"(pf[0]), "+v"(pf[1]), "+v"(pf[2]), "+v"(pf[3]));
#pragma unroll
        for (int g_ = 0; g_ < 16; ++g_) { __builtin_amdgcn_sched_group_barrier(0x008, 1, 0); __builtin_amdgcn_sched_group_barrier(0x002, 3, 0); __builtin_amdgcn_sched_group_barrier(0x100, 1, 0); }
        ATT_RESC_APPLY(); resc = false;
        ATT_BAR4();
        m3 = m3p1;
    }
    for (int i = 1; i < NT - 1; ++i) {
        const int m3p1 = (m3 == 2) ? 0 : m3 + 1, m3p2 = (m3 == 0) ? 2 : m3 - 1;
        { const int i3 = __builtin_elementwise_min(i + 3, NT - 1); const int t3 = ATT_TILE(i3); ATT_DMAK(t3, m3); }
        { const int i2 = __builtin_elementwise_min(i + 2, NT - 1); const int t2 = ATT_TILE(i2); ATT_DMAV(t2, m3p2); }
        const int t1 = ATT_TILE(i + 1);
        const LAS unsigned char* vb = lds + m3 * 16384;
        s16x4 va[8], vbb[8];
        bf16x8 pc[4];
#pragma unroll
        for (int k = 0; k < 4; ++k) pc[k] = pf[k];
        ATT_VRD(va, vb, 0);
        ATT_QK_OFF(t1, m3p1);
        ATT_VRD(vbb, vb, 1);
        if (track) { float rm; ATT_ROWMAX(rm); ATT_RESC_CHECK(rm); }
        ATT_PVC(0, va);
        ATT_VRD(va, vb, 2);
        ATT_PVC(1, vbb);
        ATT_VRD(vbb, vb, 3);
        ATT_EXP_PACK();
        ATT_PVC(2, va);
        ATT_LSUM();
        ATT_PVC(3, vbb);
        asm volatile("" : "+v"(pf[0]), "+v"(pf[1]), "+v"(pf[2]), "+v"(pf[3]));
#pragma unroll
        for (int g_ = 0; g_ < 16; ++g_) { __builtin_amdgcn_sched_group_barrier(0x008, 1, 0); __builtin_amdgcn_sched_group_barrier(0x002, 3, 0); __builtin_amdgcn_sched_group_barrier(0x100, 1, 0); }
        ATT_RESC_APPLY(); resc = false;
        ATT_BAR4();
        m3 = m3p1;
    }
    {
        const LAS unsigned char* vb = lds + m3 * 16384;
        s16x4 va[8], vbb[8]; bf16x8 pc[4];
#pragma unroll
        for (int k = 0; k < 4; ++k) pc[k] = pf[k];
        ATT_VRD(va, vb, 0); ATT_VRD(vbb, vb, 1); ATT_PVC(0, va); ATT_VRD(va, vb, 2); ATT_PVC(1, vbb); ATT_VRD(vbb, vb, 3); ATT_PVC(2, va); ATT_LSUM(); ATT_PVC(3, vbb);
        { const float lt = lsum + swap32(lsum); const float fac = ((c == 0) ? 1.0f : -lam) * __builtin_amdgcn_rcpf(lt);
          wsf[r32] = fac; asm volatile("s_waitcnt lgkmcnt(0)" ::: "memory"); __builtin_amdgcn_wave_barrier();
#pragma unroll
          for (int k = 0; k < 4; ++k) fv[k] = *(const LAS f32x4*)(wsf + 8 * k + 4 * hi);
          asm volatile("s_waitcnt lgkmcnt(0)" ::: "memory"); }
        ATT_BAR();
    }
    __builtin_amdgcn_s_setprio(0);
    if (has_next) {
        const size_t rbN = (size_t)bN * SEQ; const int d0N = 2 * qbN;
        const bf16_t* vgN0 = Z + (rbN + vrow0) * ZP + 1024 + hN * 128 + ((lane & 15) ^ (((vrow0 & 3) << 2) | ((vrow0 >> 2) & 3))) * 8;
        const bf16_t* vgN1 = Z + (rbN + vrow1) * ZP + 1024 + hN * 128 + ((lane & 15) ^ (((vrow1 & 3) << 2) | ((vrow1 >> 2) & 3))) * 8;
        ATT_DMAK_(vgN0 - 512, vgN1 - 512, d0N, 0); ATT_DMAV_(vgN0, vgN1, d0N, 0); ATT_DMAK_(vgN0 - 512, vgN1 - 512, d0N + 1, 1);
    }
#undef ATT_TILE
#undef ATT_DMAK
#undef ATT_DMAK_
#undef ATT_DMAV_
#undef ATT_BAR
#undef ATT_BAR4
#undef ATT_DMAV
#undef ATT_QK
#undef ATT_QK_OFF
#undef ATT_ROWMAX
#undef ATT_RESC_CHECK
#undef ATT_EXP_PACK
#undef ATT_RESC_APPLY
#undef ATT_VRD
#undef ATT_VF
#undef ATT_PV
#undef ATT_PVC
#undef ATT_LSUM
#undef ATT_QAUG
#undef MX3
    u32x2 gpre[8];
#pragma unroll
    for (int it = 0; it < 8; ++it) gpre[it] = *(const u32x2*)(Z + (rowbase + qb * 128 + wid * 16 + 2 * it + hi) * ZP + h * 128 + 4 * r32 + 1536);
    LAS float* Ex = (LAS float*)(lds + 65536);
    if (c == 1) {
#pragma unroll
        for (int cc = 0; cc < 4; ++cc)
#pragma unroll
            for (int r = 0; r < 16; ++r) Ex[(qs * 32 + crow(r, hi)) * EXP + cc * 32 + r32] = o[cc][r] * fv[r >> 2][r & 3];
    }
    __syncthreads();
    if (c == 0) {
#pragma unroll
        for (int cc = 0; cc < 4; ++cc)
#pragma unroll
            for (int r = 0; r < 16; ++r) { LAS float* p = Ex + (qs * 32 + crow(r, hi)) * EXP + cc * 32 + r32; *p = *p + o[cc][r] * fv[r >> 2][r & 3]; }
    }
    __syncthreads();
    { const f32x4 sg = *(const f32x4*)(subg + 4 * r32);
#pragma unroll
      for (int it = 0; it < 8; ++it) { const int row = wid * 16 + 2 * it + hi;
        const f32x4 v = *(const LAS f32x4*)(Ex + row * EXP + 4 * r32);
        float ss = (v[0] * v[0] + v[1] * v[1]) + (v[2] * v[2] + v[3] * v[3]);
        ss += __shfl_xor(ss, 1); ss += __shfl_xor(ss, 2); ss += __shfl_xor(ss, 4); ss += __shfl_xor(ss, 8); ss += __shfl_xor(ss, 16);
        const float rs = __builtin_amdgcn_rsqf(ss * (1.0f / 128.0f) + 1e-6f) * oml;
        bf16_t* zr = Z + (rowbase + qb * 128 + row) * ZP + h * 128 + 4 * r32;
        const u32x2 gw = gpre[it];
        const float o0 = v[0] * rs * sg[0] * silu(bflo(gw.x)), o1 = v[1] * rs * sg[1] * silu(bfhi(gw.x)), o2 = v[2] * rs * sg[2] * silu(bflo(gw.y)), o3 = v[3] * rs * sg[3] * silu(bfhi(gw.y));
        u32x2 ow; ow.x = cvtpk(o0, o1); ow.y = cvtpk(o2, o3); if (!dry) *(u32x2*)zr = ow; } }
    __syncthreads();
}

__device__ __forceinline__ void sgu_unit(LAS unsigned char* lds, bf16_t* Z, int b, int chunk, const float* vng, const bf16_t* Wsb, const float* bs, const int wave_in, bool dry = false) {
    int tid_ = wave_in * 64 + lane_now(); asm volatile("" : "+v"(tid_));
    const int tid = tid_, lane = tid & 63, r32 = lane & 31, hi = lane >> 5; const int wid = __builtin_amdgcn_readfirstlane(tid >> 6);
    const size_t rowbase = (size_t)b * SEQ + (size_t)chunk * 128;
    { f32x4 g0 = *(const f32x4*)(vng + lane * 8), g1 = *(const f32x4*)(vng + lane * 8 + 4);
#pragma unroll 8
      for (int it = 0; it < 16; ++it) { const int row = wid * 16 + it;
        const u32x4 raw = *(const u32x4*)(Z + (rowbase + row) * ZP + 2560 + lane * 8);
        float x[8] = {bflo(raw.x), bfhi(raw.x), bflo(raw.y), bfhi(raw.y), bflo(raw.z), bfhi(raw.z), bflo(raw.w), bfhi(raw.w)};
        float ss = 0.f;
#pragma unroll
        for (int j = 0; j < 8; ++j) ss += x[j] * x[j];
#pragma unroll
        for (int of = 1; of < 64; of <<= 1) ss += __shfl_xor(ss, of);
        const float rs = __builtin_amdgcn_rsqf(ss * (1.0f / 512.0f) + 1e-6f);
        u32x4 w; w.x = cvtpk(x[0] * rs * g0[0], x[1] * rs * g0[1]); w.y = cvtpk(x[2] * rs * g0[2], x[3] * rs * g0[3]); w.z = cvtpk(x[4] * rs * g1[0], x[5] * rs * g1[1]); w.w = cvtpk(x[6] * rs * g1[2], x[7] * rs * g1[3]);
        *(LAS u32x4*)(lds + (lane >> 4) * 32768 + vst_off(row, lane & 15)) = w; } }
    __syncthreads();
    const int tb = wid & 3, dh = wid >> 2;
    unsigned va[2][2];
#pragma unroll
    for (int c2 = 0; c2 < 2; ++c2) { va[c2][0] = vtr_off(lane, dh * 2 + c2, 0); va[c2][1] = vtr_off(lane, dh * 2 + c2, 1); }
    for (int g = 0; g < 4; ++g) {
        bf16x8 af[8];
        { const bf16_t* wp = Wsb + ((size_t)(g * 128 + tb * 32 + r32)) * 128 + 4 * hi;
#pragma unroll
          for (int ks = 0; ks < 8; ++ks) { const u32x2 lo = *(const u32x2*)(wp + 16 * ks), hh = *(const u32x2*)(wp + 16 * ks + 8); u32x4 w; w.x = lo.x; w.y = lo.y; w.z = hh.x; w.w = hh.y; af[ks] = __builtin_bit_cast(bf16x8, w); } }
        f32x16 acc[2]; acc[0] = f32x16{}; acc[1] = f32x16{};
        const LAS unsigned char* tbp = lds + g * 32768;
#pragma unroll
        for (int c2 = 0; c2 < 2; ++c2)
#pragma unroll
            for (int ks = 0; ks < 8; ++ks) { const s16x4 lo = vtr(tbp + va[c2][0] + ks * 4096), hh = vtr(tbp + va[c2][1] + ks * 4096);
                const bf16x8 vf = (bf16x8){lo[0], lo[1], lo[2], lo[3], hh[0], hh[1], hh[2], hh[3]};
                acc[c2] = __builtin_amdgcn_mfma_f32_32x32x16_bf16(af[ks], vf, acc[c2], 0, 0, 0); }
        unsigned short uu_[2][16], gg_[2][16];
#pragma unroll
        for (int c2 = 0; c2 < 2; ++c2)
#pragma unroll
            for (int r = 0; r < 16; ++r) { const int t = tb * 32 + crow(r, hi); const int col = g * 128 + (dh * 2 + c2) * 32 + r32;
                const bf16_t* zp = Z + (rowbase + t) * ZP + 2048 + col; uu_[c2][r] = zp[0]; gg_[c2][r] = zp[1024]; }
#pragma unroll
        for (int c2 = 0; c2 < 2; ++c2)
#pragma unroll
            for (int r = 0; r < 16; ++r) { const int t = tb * 32 + crow(r, hi); const int col = g * 128 + (dh * 2 + c2) * 32 + r32;
                bf16_t* zp = Z + (rowbase + t) * ZP + 2048 + col;
                const float sv = acc[c2][r] + bs[g * 128 + t];
                const float ov = bf2f(uu_[c2][r]) * sv * silu(bf2f(gg_[c2][r]));
                if (!dry) zp[0] = (bf16_t)(cvtpk(ov, 0.f) & 0xffffu); }
    }
    __syncthreads();
}
#undef LAS
}
#define LAS __attribute__((address_space(3)))
typedef unsigned short bf16;
typedef unsigned v4u __attribute__((ext_vector_type(4)));
typedef float f32x4 __attribute__((ext_vector_type(4)));
constexpr int NWAVES = 8, NTHREADS = 512;
constexpr int DM = 1024, DIN = 3584, DEPTH = 4, SEQ = 4096, NB_P = 8, NB_S = 16, NB = 24;
constexpr int M = NB * SEQ;
constexpr int M_P = NB_P * SEQ;
constexpr size_t MiB = 1u << 20;
constexpr size_t WS_MISC = 0;
constexpr size_t WS_HMAX = 65536;
constexpr size_t WS_WIN = 1 * MiB;
constexpr size_t WS_WOUT = 30 * MiB;
constexpr size_t WS_WS = 39 * MiB;
constexpr size_t WS_SSQ = 40 * MiB;
constexpr size_t WS_XB = 44 * MiB;
constexpr size_t WS_Z = 240 * MiB;
constexpr size_t WS_END = WS_Z + (size_t)M * DIN * 2;
static_assert(WS_XB + (size_t)M * DM * 2 <= WS_Z && WS_END <= (size_t)1024 * MiB, "d_ws map");
constexpr int LDS_BYTES = 139264;

__device__ __forceinline__ unsigned f2bf(float f) { unsigned u = __builtin_bit_cast(unsigned, f); return (u + 0x7fffu + ((u >> 16) & 1u)) >> 16; }
__device__ __forceinline__ unsigned pk2(float lo, float hi) { return f2bf(lo) | (f2bf(hi) << 16); }
__device__ __forceinline__ float wave_sum(float v) {
#pragma unroll
    for (int o = 1; o < 64; o <<= 1) v += __shfl_xor(v, o);
    return v;
}
__device__ __forceinline__ void transpose_item(const float* W, int K, int N, bf16* WT, const float* gsc, LAS float* scr, int item, int lane) {
    const int nblk = N / 32, kb = item / nblk, nb = item % nblk, k0 = 64 * kb, n0 = 32 * nb;
#pragma unroll 8
    for (int i = 0; i < 32; ++i) { const int kk = 2 * i + (lane >> 5); const float sc = gsc ? gsc[k0 + kk] : 1.0f; scr[kk * 33 + (lane & 31)] = W[(size_t)(k0 + kk) * N + n0 + (lane & 31)] * sc; }
    asm volatile("s_waitcnt lgkmcnt(0)" ::: "memory");
    const int c = lane & 7;
#pragma unroll
    for (int j = 0; j < 4; ++j) { const int n = (lane >> 3) + 8 * j; const LAS float* s = scr + (8 * c) * 33 + n;
        v4u o; o.x = pk2(s[0 * 33], s[1 * 33]); o.y = pk2(s[2 * 33], s[3 * 33]); o.z = pk2(s[4 * 33], s[5 * 33]); o.w = pk2(s[6 * 33], s[7 * 33]);
        *(v4u*)(WT + (size_t)(n0 + n) * K + k0 + 8 * c) = o; }
    asm volatile("s_waitcnt lgkmcnt(0)" ::: "memory");
}

struct Args { const float* xp; const float* xs; const float* norm_g; const float* w_in; const float* lambda_qk; const float* subln_g; const float* vnorm_g;
              const float* w_s; const float* b_s; const float* w_out; const float* final_g; float* out; unsigned char* ws; };

__global__ void __launch_bounds__(NTHREADS) hymba_fwd(Args a) {
    extern __shared__ __attribute__((aligned(16))) unsigned char lds_raw[];
    LAS unsigned char* lds = (LAS unsigned char*)lds_raw;
    cg::grid_group grid = cg::this_grid();
    const int tid = threadIdx.x, lane = tid & 63; const int wave = __builtin_amdgcn_readfirstlane(tid >> 6);
    const int G = gridDim.x, bx = blockIdx.x;
    const int vcu = (G % 8 == 0) ? (bx % 8) * (G / 8) + bx / 8 : bx;
    unsigned char* ws = a.ws;
    float* misc = (float*)(ws + WS_MISC);
    unsigned* hmax = (unsigned*)(ws + WS_HMAX);
    bf16* WinT = (bf16*)(ws + WS_WIN); bf16* WoutT = (bf16*)(ws + WS_WOUT); bf16* Wsb = (bf16*)(ws + WS_WS);
    unsigned long long* ssq = (unsigned long long*)(ws + WS_SSQ);
    bf16* XB = (bf16*)(ws + WS_XB); bf16* Z = (bf16*)(ws + WS_Z);

    {
        const int gw = vcu * NWAVES + wave, NGW = G * NWAVES;
        LAS float* scr = (LAS float*)(lds + wave * 16384);
        constexpr int I_IN = (DM / 64) * (DIN / 32), I_OUT = (DM / 64) * (DM / 32), I_L = I_IN + I_OUT;
        for (int it = gw; it < DEPTH * I_L; it += NGW) { const int l = it / I_L; int r = it % I_L;
            if (r < I_IN) transpose_item(a.w_in + (size_t)l * DM * DIN, DM, DIN, WinT + (size_t)l * DIN * DM, a.norm_g + l * DM, scr, r, lane);
            else transpose_item(a.w_out + (size_t)l * DM * DM, DM, DM, WoutT + (size_t)l * DM * DM, nullptr, scr, r - I_IN, lane); }
        for (int i = (bx * NTHREADS + tid); i < DEPTH * 4 * 128 * 128 / 2; i += G * NTHREADS) { const float2 v = ((const float2*)a.w_s)[i]; ((unsigned*)Wsb)[i] = pk2(v.x, v.y); }
        for (int i = (bx * NTHREADS + tid); i < 4 * M; i += G * NTHREADS) ssq[M + i] = 0ull;
        for (int i = (bx * NTHREADS + tid); i < DEPTH * NB * 32; i += G * NTHREADS) hmax[i] = 0u;
        for (int m0 = gw; m0 < M; m0 += 4 * NGW) {
            f32x4 v[4][4];
#pragma unroll
            for (int q = 0; q < 4; ++q) { const int m = m0 + q * NGW; if (m < M) { const float* xr = (m < M_P) ? a.xp + (size_t)m * DM : a.xs + (size_t)(m - M_P) * DM; const f32x4* x4 = (const f32x4*)xr + lane;
#pragma unroll
                for (int j = 0; j < 4; ++j) v[q][j] = x4[64 * j]; } }
#pragma unroll
            for (int q = 0; q < 4; ++q) { const int m = m0 + q * NGW; if (m < M) { float s = 0.f;
#pragma unroll
                for (int j = 0; j < 4; ++j) s += (v[q][j].x * v[q][j].x + v[q][j].y * v[q][j].y) + (v[q][j].z * v[q][j].z + v[q][j].w * v[q][j].w);
                s = wave_sum(s);
                if (lane == 0) ssq[m] = (unsigned long long)(s * pg8::SSQ_SCALE);
                unsigned long long* o8 = (unsigned long long*)(XB + (size_t)m * DM) + lane;
#pragma unroll
                for (int j = 0; j < 4; ++j) o8[64 * j] = (unsigned long long)pk2(v[q][j].x, v[q][j].y) | ((unsigned long long)pk2(v[q][j].z, v[q][j].w) << 32); } }
        }
        if (bx == 0 && wave == 0) {
            for (int l = 0; l < DEPTH; ++l) { const float* lq = a.lambda_qk + l * 256;
                const float s1 = wave_sum(lq[lane] * lq[64 + lane]), s2 = wave_sum(lq[128 + lane] * lq[192 + lane]);
                const float li = 0.8f - 0.6f * expf(-0.3f * (float)l);
                if (lane == 0) { misc[2 * l] = expf(s1) - expf(s2) + li; misc[2 * l + 1] = li; } }
        }
    }
    grid.sync();

    for (int l = 0; l < DEPTH; ++l) {
        {
            pg8::Gemm g{XB, WinT + (size_t)l * DIN * DM, M, DIN, DM, DM, 0}; pg8::StaticOrder S; S.init(M, DIN, G, bx);
            pg8::EpiZ E{Z, ssq + (size_t)l * M, 0.125f * 1.4426950408889634f, hmax + l * NB * 32};
#ifndef NO_GEMM1
            pg8::gemm_phase<pg8::EpiZ, pg8::StaticOrder, true, true>(lds, g, S, E, wave);
#endif
#ifdef PROBE_GEMM1X2
            grid.sync();
#ifdef PROBE_SYNC2
        grid.sync(); grid.sync(); grid.sync(); grid.sync();
#endif
            pg8::gemm_phase<pg8::EpiZ, pg8::StaticOrder, true, true>(lds, g, S, E, wave);
#endif
        }
        grid.sync();
#ifdef PROBE_SYNC2
        grid.sync(); grid.sync(); grid.sync(); grid.sync();
#endif
        {
            const float lam = __uint_as_float(__builtin_amdgcn_readfirstlane(__float_as_uint(misc[2 * l]))), li = __uint_as_float(__builtin_amdgcn_readfirstlane(__float_as_uint(misc[2 * l + 1])));
            const unsigned* hmaxL = hmax + l * NB * 32;
            const int nper = G / 8, xcd = vcu / nper, slot = vcu % nper;
#ifndef NO_ATT
            const int nunits = (G == 256) ? 12 : (NB * 4 * 32 - bx + G - 1) / G;
            for (int i = 0; i < nunits; ++i) { int pair, qb, pairN, qbN;
                if (G == 256) { pair = i * 8 + ((xcd + i) & 7); qb = (slot + 11 * i) & 31; pairN = (i + 1) * 8 + ((xcd + i + 1) & 7); qbN = (slot + 11 * (i + 1)) & 31; }
                else { const int u = bx + i * G; pair = u >> 5; qb = u & 31; pairN = (u + G) >> 5; qbN = (u + G) & 31; }
                const int b = pair >> 2, h = pair & 3;
                const float slope2 = exp2f(-2.0f * (float)(h + 1)) * 1.4426950408889634f;
                int W; float Rg;
                { const unsigned* hp = hmaxL + b * 32 + h * 4; float R2 = 0.f;
                  for (int c = 0; c < 2; ++c) { const float q2 = __uint_as_float(__builtin_amdgcn_readfirstlane(hp[2 * c])) + __uint_as_float(__builtin_amdgcn_readfirstlane(hp[2 * c + 1]));
                      const float k2 = __uint_as_float(__builtin_amdgcn_readfirstlane(hp[16 + 2 * c])) + __uint_as_float(__builtin_amdgcn_readfirstlane(hp[16 + 2 * c + 1])); R2 = fmaxf(R2, q2 * k2); }
                  const float R = sqrtf(R2) * 1.02f + 0.5f; Rg = R; const float dd = (160.0f + 2.0f * R) / slope2;
                  const float wf = floorf((dd - 1.0f) * (1.0f / 64.0f)) + 1.0f; W = (wf >= 62.0f) ? 62 : (wf < 0.f ? 0 : (int)wf); }
                const bool track = !(Rg <= 48.0f);
                mix::attn_unit(lds, Z, b, h, qb, slope2, lam, 1.0f - li, a.subln_g + l * 128, wave, W, track, i == 0, i + 1 < nunits, pairN >> 2, pairN & 3, qbN); }
#endif
#ifndef NO_SGU
#ifdef PROBE_SGU2
            for (int u = bx; u < NB * 32; u += G)
                mix::sgu_unit(lds, Z, u >> 5, u & 31, a.vnorm_g + l * 512, Wsb + (size_t)l * 4 * 128 * 128, a.b_s + l * 512, wave, true);
#endif
            for (int u = bx; u < NB * 32; u += G)
                mix::sgu_unit(lds, Z, u >> 5, u & 31, a.vnorm_g + l * 512, Wsb + (size_t)l * 4 * 128 * 128, a.b_s + l * 512, wave);
#endif
        }
        grid.sync();
#ifdef PROBE_SYNC2
        grid.sync(); grid.sync(); grid.sync(); grid.sync();
#endif
        {
            pg8::Gemm g{Z, WoutT + (size_t)l * DM * DM, M, DM, DM, DIN, 3072}; pg8::StaticOrder S; S.init(M, DM, G, bx);
            pg8::EpiRes E{XB, ssq + (size_t)(l + 1) * M, false};
#ifdef PROBE_GEMM2X2
            { pg8::EpiRes E2 = E; E2.dry = true; pg8::gemm_phase<pg8::EpiRes, pg8::StaticOrder, true, true>(lds, g, S, E2, wave); grid.sync(); }
#endif
#ifndef NO_GEMM2
            pg8::gemm_phase<pg8::EpiRes, pg8::StaticOrder, true, true>(lds, g, S, E, wave);
#endif
        }
        grid.sync();
#ifdef PROBE_SYNC2
        grid.sync(); grid.sync(); grid.sync(); grid.sync();
#endif
    }
    {
        int lane_ = lane_now(); asm volatile("" : "+v"(lane_)); const int lane = lane_;
        const int gw = vcu * NWAVES + wave, NGW = G * NWAVES;
        const f32x4* g4 = (const f32x4*)a.final_g + lane; f32x4 gv[4];
#pragma unroll
        for (int j = 0; j < 4; ++j) gv[j] = g4[64 * j];
        for (int m0 = gw; m0 < M; m0 += 4 * NGW) {
            unsigned long long w[4][4]; unsigned long long sq[4];
#pragma unroll
            for (int q = 0; q < 4; ++q) { const int m = m0 + q * NGW; if (m < M) { sq[q] = ssq[(size_t)4 * M + m]; const unsigned long long* xr = (const unsigned long long*)(XB + (size_t)m * DM) + lane;
#pragma unroll
                for (int j = 0; j < 4; ++j) w[q][j] = xr[64 * j]; } }
#pragma unroll
            for (int q = 0; q < 4; ++q) { const int m = m0 + q * NGW; if (m < M) {
                const float rs = __builtin_amdgcn_rsqf((float)sq[q] * (pg8::SSQ_INV / 1024.0f) + 1e-6f);
                f32x4* o4 = (f32x4*)(a.out + (size_t)m * DM) + lane;
#pragma unroll
                for (int j = 0; j < 4; ++j) { const unsigned lo = (unsigned)w[q][j], hi = (unsigned)(w[q][j] >> 32);
                    f32x4 v = {__uint_as_float(lo << 16), __uint_as_float(lo & 0xffff0000u), __uint_as_float(hi << 16), __uint_as_float(hi & 0xffff0000u)};
                    o4[64 * j] = v * rs * gv[j]; } } }
        }
    }
}

extern "C" void kernel_launch(void* const* d_in, const int* in_sizes, int n_in, void* d_out, int out_size, void* d_ws, size_t ws_size, hipStream_t stream) {
    static int grid = 0;
    if (grid == 0) {
        if (n_in != 11 || in_sizes[0] != M_P * DM || out_size != M * DM || ws_size < WS_END) { fprintf(stderr, "kernel_launch: unexpected shapes (n_in %d in0 %d out %d ws %zu)\n", n_in, n_in > 0 ? in_sizes[0] : -1, out_size, ws_size); grid = -1; return; }
        int dev = 0, cus = 0, per_cu = 0;
        if (hipGetDevice(&dev) != hipSuccess || hipDeviceGetAttribute(&cus, hipDeviceAttributeMultiprocessorCount, dev) != hipSuccess) { grid = -1; return; }
        if (hipFuncSetAttribute((const void*)hymba_fwd, hipFuncAttributeMaxDynamicSharedMemorySize, LDS_BYTES) != hipSuccess) { fprintf(stderr, "kernel_launch: hipFuncSetAttribute failed\n"); grid = -1; return; }
        if (hipOccupancyMaxActiveBlocksPerMultiprocessor(&per_cu, (const void*)hymba_fwd, NTHREADS, LDS_BYTES) != hipSuccess || per_cu < 1) { fprintf(stderr, "kernel_launch: occupancy query says %d blocks per CU\n", per_cu); per_cu = 1; }
        (void)hipGetLastError();
        grid = cus;
    }
    if (grid < 0) return;
    Args a{};
    a.xp = (const float*)d_in[0]; a.xs = (const float*)d_in[1]; a.norm_g = (const float*)d_in[2]; a.w_in = (const float*)d_in[3]; a.lambda_qk = (const float*)d_in[4];
    a.subln_g = (const float*)d_in[5]; a.vnorm_g = (const float*)d_in[6]; a.w_s = (const float*)d_in[7]; a.b_s = (const float*)d_in[8]; a.w_out = (const float*)d_in[9]; a.final_g = (const float*)d_in[10];
    a.out = (float*)d_out; a.ws = (unsigned char*)d_ws;
    void* args[] = {&a};
    hipError_t e = hipLaunchCooperativeKernel((const void*)hymba_fwd, dim3(grid), dim3(NTHREADS), args, LDS_BYTES, stream);
    if (e != hipSuccess) fprintf(stderr, "kernel_launch: cooperative launch failed: %s (grid %d)\n", hipGetErrorString(e), grid);
}
```

```cpp
#include <hip/hip_runtime.h>
#include <hip/hip_bf16.h>
#include <hip/hip_cooperative_groups.h>
#include <cstdio>
#include <cstdint>
#include <cmath>
namespace cg = cooperative_groups;
__device__ __forceinline__ int lane_now() { unsigned z; asm volatile("s_mov_b32 %0, 0" : "=s"(z)); return (int)__builtin_amdgcn_mbcnt_hi(~0u, __builtin_amdgcn_mbcnt_lo(~0u, z)); }
namespace pg8 {
#define PG8_LAS __attribute__((address_space(3)))
typedef unsigned short bf16_t;
typedef short bf16x8 __attribute__((ext_vector_type(8)));
typedef float f32x4 __attribute__((ext_vector_type(4)));
typedef unsigned u32x4 __attribute__((ext_vector_type(4)));
constexpr int BM = 256, BK = 64, HALF = 128, HTB = HALF * BK * 2  , STAGE_BYTES = 8 * HTB, NXCD = 8, WGM = 8;

__host__ __device__ __forceinline__ int lds_byte(int r, int c) { const int st = (r >> 4) * 2 + (c >> 5), rr = r & 15, cc = c & 31, ob = rr * 64 + cc * 2; return st * 1024 + (ob ^ (((ob >> 9) & 1) << 5)); }
__host__ __device__ __forceinline__ void stage_rc(int b, int& R, int& C) { const int st = b / 1024, sb = b % 1024, swz = sb ^ (((sb >> 9) & 1) << 5); R = (st >> 1) * 16 + swz / 64; C = (st & 1) * 32 + (swz % 64) / 2; }
__host__ __device__ __forceinline__ int perm32(int rho) { const int n = rho >> 4, i = rho & 15; return 8 * (i >> 2) + 4 * n + (i & 3); }

struct Unit { int pm, pn; };
struct Gemm { const bf16_t* A; const bf16_t* Bt; int M, N, K, lda, kjump; };

struct StaticOrder {
    int nM, nN, nwg, G, c;
    __host__ __device__ void init(int M, int N, int G_, int c_) { nM = M / BM; nN = N / BM; nwg = nM * nN; G = G_; c = c_; }
    __host__ __device__ bool next(int i, Unit& u) const {
        const long L = (long)i * G + c; if (L >= nwg) return false;
        int wgid = (int)L; { const int q = nwg / NXCD, r = nwg % NXCD, xcd = wgid % NXCD, off = wgid / NXCD; wgid = (xcd < r ? xcd * (q + 1) : r * (q + 1) + (xcd - r) * q) + off; }
        const int nig = WGM * nN, gid = wgid / nig, fm = gid * WGM, gsz = (nM - fm) < WGM ? (nM - fm) : WGM;
        u.pm = fm + ((wgid % nig) % gsz); u.pn = (wgid % nig) / gsz; return true;
    }
    __device__ __forceinline__ void a_ready(const Unit&) const {}
    __device__ __forceinline__ void done(const Unit&) const {}
};

__device__ __forceinline__ unsigned cvt_pk_bf16(float lo, float hi) { unsigned r; asm volatile("v_cvt_pk_bf16_f32 %0, %1, %2" : "=v"(r) : "v"(lo), "v"(hi)); return r; }
constexpr int SSQ_SHIFT = 24;
constexpr float SSQ_SCALE = 16777216.0f, SSQ_INV = 1.0f / 16777216.0f;
struct EpiZ {
    static constexpr bool PERM = true, AFTER_DRAIN = false;
    bf16_t* Z; const unsigned long long* ssq; float c2; unsigned* hmax;
    __device__ __forceinline__ void operator()(const f32x4 (&acc)[2][2][4][2], const Unit& u, int wr, int wc, int fr, int fq) const {
        const int row0 = u.pm * BM + wr * 64 + fr; const int col0 = u.pn * BM + wc * 32 + 8 * fq;
        const float sc = (u.pn < 2) ? c2 : 1.0f;
        float hm0 = 0.f, hm1 = 0.f;
        unsigned long long sq[8];
#pragma unroll
        for (int i = 0; i < 8; ++i) sq[i] = ssq[row0 + (i >> 2) * HALF + (i & 3) * 16];
#pragma unroll
        for (int ai = 0; ai < 2; ++ai)
#pragma unroll
            for (int m = 0; m < 4; ++m) { const int row = row0 + ai * HALF + m * 16;
                const float ms = (float)sq[ai * 4 + m] * (SSQ_INV / 1024.0f);
                const float rs = __builtin_amdgcn_rsqf(ms + 1e-6f) * sc;
                bf16_t* rowp = Z + (size_t)row * 3584 + col0;
#pragma unroll
                for (int bj = 0; bj < 2; ++bj) { const f32x4 v0 = acc[ai][bj][m][0] * rs, v1 = acc[ai][bj][m][1] * rs;
                    u32x4 w; w.x = cvt_pk_bf16(v0[0], v0[1]); w.y = cvt_pk_bf16(v0[2], v0[3]); w.z = cvt_pk_bf16(v1[0], v1[1]); w.w = cvt_pk_bf16(v1[2], v1[3]);
                    *(u32x4*)(rowp + bj * HALF) = w;
                    if (u.pn < 4) { float q = (v0[0] * v0[0] + v0[1] * v0[1]) + (v0[2] * v0[2] + v0[3] * v0[3]) + (v1[0] * v1[0] + v1[1] * v1[1]) + (v1[2] * v1[2] + v1[3] * v1[3]);
                        q += __shfl_xor(q, 16); q += __shfl_xor(q, 32); if (bj == 0) hm0 = __builtin_fmaxf(hm0, q); else hm1 = __builtin_fmaxf(hm1, q); } } }
        if (u.pn < 4) {
#pragma unroll
            for (int o = 1; o < 16; o <<= 1) { hm0 = __builtin_fmaxf(hm0, __shfl_xor(hm0, o)); hm1 = __builtin_fmaxf(hm1, __shfl_xor(hm1, o)); }
            if (fr == 0 && fq == 0) { unsigned* hp = hmax + (u.pm >> 4) * 32 + u.pn * 8 + wc; atomicMax(hp, __float_as_uint(hm0)); atomicMax(hp + 4, __float_as_uint(hm1)); } }
    }
};
struct EpiRes {
    static constexpr bool PERM = true, AFTER_DRAIN = false;
    bf16_t* xb; unsigned long long* ssqn; bool dry;
    __device__ __forceinline__ void operator()(const f32x4 (&acc)[2][2][4][2], const Unit& u, int wr, int wc, int fr, int fq) const {
        const int row0 = u.pm * BM + wr * 64 + fr; const int col0 = u.pn * BM + wc * 32 + 8 * fq;
        u32x4 pre[2][4][2];
#pragma unroll
        for (int ai = 0; ai < 2; ++ai)
#pragma unroll
            for (int m = 0; m < 4; ++m)
#pragma unroll
                for (int bj = 0; bj < 2; ++bj) pre[ai][m][bj] = *(const u32x4*)(xb + (size_t)(row0 + ai * HALF + m * 16) * 1024 + col0 + bj * HALF);
#pragma unroll
        for (int ai = 0; ai < 2; ++ai)
#pragma unroll
            for (int m = 0; m < 4; ++m) { const int row = row0 + ai * HALF + m * 16; const size_t off = (size_t)row * 1024 + col0; float ss = 0.f;
#pragma unroll
                for (int bj = 0; bj < 2; ++bj) { const u32x4 bw = pre[ai][m][bj];
                    const f32x4 b0 = {__uint_as_float(bw.x << 16), __uint_as_float(bw.x & 0xffff0000u), __uint_as_float(bw.y << 16), __uint_as_float(bw.y & 0xffff0000u)};
                    const f32x4 b1 = {__uint_as_float(bw.z << 16), __uint_as_float(bw.z & 0xffff0000u), __uint_as_float(bw.w << 16), __uint_as_float(bw.w & 0xffff0000u)};
                    const f32x4 v0 = acc[ai][bj][m][0] + b0, v1 = acc[ai][bj][m][1] + b1;
                    u32x4 w; w.x = cvt_pk_bf16(v0[0], v0[1]); w.y = cvt_pk_bf16(v0[2], v0[3]); w.z = cvt_pk_bf16(v1[0], v1[1]); w.w = cvt_pk_bf16(v1[2], v1[3]);
                    if (!dry) *(u32x4*)(xb + off + bj * HALF) = w;
                    ss += (v0[0] * v0[0] + v0[1] * v0[1]) + (v0[2] * v0[2] + v0[3] * v0[3]) + (v1[0] * v1[0] + v1[1] * v1[1]) + (v1[2] * v1[2] + v1[3] * v1[3]); }
                ss += __shfl_xor(ss, 16); ss += __shfl_xor(ss, 32);
                if (fq == 0 && (!dry || ss < 0.f)) atomicAdd(ssqn + row, (unsigned long long)(ss * SSQ_SCALE)); }
    }
};
template <class Epi, class Sched, bool ALIGN_EPI = false, bool SP2 = false>
__device__ __forceinline__ void gemm_phase(PG8_LAS unsigned char* lds, const Gemm g, const Sched& S, const Epi& E, const int wave_in) {
    int tid_ = wave_in * 64 + lane_now(); asm volatile("" : "+v"(tid_));
    const int tid = tid_, wid = __builtin_amdgcn_readfirstlane(tid >> 6), lane = tid & 63, wr = wid >> 2, wc = wid & 3, fr = lane & 15, fq = lane >> 4;
    const int K = g.K, nt = K / BK;
    unsigned voffA[2], voffB[2];
#pragma unroll
    for (int i = 0; i < 2; ++i) { int R, C; stage_rc(tid * 16 + i * 8192, R, C); const int Rb = Epi::PERM ? ((R & ~31) + perm32(R & 31)) : R;
        voffA[i] = (unsigned)(R * g.lda + C) * 2u; voffB[i] = (unsigned)(Rb * K + C) * 2u; }
    const size_t kstep = (size_t)(BK * 2);
    const size_t hstepA = (size_t)HALF * g.lda * 2, hstepB = (size_t)HALF * K * 2;
    const size_t tstepA = 2 * hstepA, tstepB = 2 * hstepB;
    const size_t kjump = (size_t)g.kjump;
#define PG8_KOFFA(t) ((size_t)(t) * kstep + ((t) >= 8 ? kjump : (size_t)0))
    const unsigned ldsw = (unsigned)wid * 1024u;
    const int aoff = lds_byte(wr * 64 + fr, fq * 8), boff = lds_byte(wc * 32 + fr, fq * 8);
#define PG8_SA(b, h) (((b) * 2 + (h)) * HTB)
#define PG8_SB(b, h) ((4 + (b) * 2 + (h)) * HTB)
#define PG8_STAGE(bufoff, gbase, voff) do { _Pragma("unroll") for (int _i = 0; _i < 2; ++_i) \
        __builtin_amdgcn_global_load_lds((const unsigned*)((const char*)(gbase) + (voff)[_i]), (PG8_LAS unsigned*)(lds + (bufoff) + ldsw + _i * 8192), 16, 0, 0); } while (0)
#define PG8_LDA(dst, b, h) do { _Pragma("unroll") for (int m = 0; m < 4; ++m) _Pragma("unroll") for (int k = 0; k < 2; ++k) dst[m][k] = *(const PG8_LAS bf16x8*)(lds + PG8_SA(b, h) + aoff + m * 2048 + k * 1024); } while (0)
#define PG8_LDB(dst, b, h) do { _Pragma("unroll") for (int n = 0; n < 2; ++n) _Pragma("unroll") for (int k = 0; k < 2; ++k) dst[n][k] = *(const PG8_LAS bf16x8*)(lds + PG8_SB(b, h) + boff + n * 2048 + k * 1024); } while (0)
#define PG8_MMA(ai, bj, At, Bt) do { __builtin_amdgcn_s_setprio(1); _Pragma("unroll") for (int m = 0; m < 4; ++m) _Pragma("unroll") for (int n = 0; n < 2; ++n) _Pragma("unroll") for (int k = 0; k < 2; ++k) \
        acc[ai][bj][m][n] = __builtin_amdgcn_mfma_f32_16x16x32_bf16(Bt[n][k], At[m][k], acc[ai][bj][m][n], 0, 0, 0); __builtin_amdgcn_s_setprio(0); } while (0)
#define PG8_WAIT_V(n) asm volatile("s_waitcnt vmcnt(" #n ")" ::: "memory")
#define PG8_WAIT_L(n) asm volatile("s_waitcnt lgkmcnt(" #n ")" ::: "memory")
#define PG8_BAR __builtin_amdgcn_s_barrier()
#define PG8_SCHED __builtin_amdgcn_sched_barrier(0)
    Unit cur, nxt; int ui = 0;
    if (!S.next(0, cur)) return;
    f32x4 acc[2][2][4][2];
#pragma unroll
    for (int a = 0; a < 2; ++a)
#pragma unroll
        for (int b = 0; b < 2; ++b)
#pragma unroll
            for (int m = 0; m < 4; ++m)
#pragma unroll
                for (int n = 0; n < 2; ++n) acc[a][b][m][n] = (f32x4){0.f, 0.f, 0.f, 0.f};
    bf16x8 At[4][2], B0[2][2], B1[2][2];
    const char* cA = (const char*)g.A + (size_t)cur.pm * tstepA; const char* cB = (const char*)g.Bt + (size_t)cur.pn * tstepB;
    S.a_ready(cur);
    if constexpr (SP2) {
        PG8_STAGE(PG8_SB(0, 0), cB, voffB); PG8_STAGE(PG8_SB(0, 1), cB + hstepB, voffB); PG8_STAGE(PG8_SA(0, 0), cA, voffA); PG8_STAGE(PG8_SA(0, 1), cA + hstepA, voffA);
        if (wr == 1) PG8_BAR;
        PG8_WAIT_V(2); PG8_BAR;
        PG8_STAGE(PG8_SB(1, 0), cB + kstep, voffB); PG8_STAGE(PG8_SA(1, 0), cA + kstep, voffA); PG8_STAGE(PG8_SB(1, 1), cB + hstepB + kstep, voffB);
        PG8_WAIT_V(6); PG8_BAR;
    } else {
        PG8_STAGE(PG8_SB(0, 0), cB, voffB); PG8_STAGE(PG8_SA(0, 0), cA, voffA); PG8_STAGE(PG8_SB(0, 1), cB + hstepB, voffB); PG8_STAGE(PG8_SA(0, 1), cA + hstepA, voffA);
        if (wr == 1) PG8_BAR;
        PG8_WAIT_V(4); PG8_BAR;
        PG8_STAGE(PG8_SB(1, 0), cB + kstep, voffB); PG8_STAGE(PG8_SA(1, 0), cA + kstep, voffA); PG8_STAGE(PG8_SB(1, 1), cB + hstepB + kstep, voffB);
        PG8_WAIT_V(6); PG8_BAR;
    }
    for (;;) {
        const bool has_next = S.next(ui + 1, nxt);
        const char* nA = has_next ? (const char*)g.A + (size_t)nxt.pm * tstepA : cA; const char* nB = has_next ? (const char*)g.Bt + (size_t)nxt.pn * tstepB : cB;
        for (int t = 0; t < nt; t += 2) {
            const bool last = (t == nt - 2);
            const char* a1 = cA + PG8_KOFFA(t + 1);
            const char* a2 = last ? nA : cA + PG8_KOFFA(t + 2); const char* b2 = last ? nB : cB + (size_t)(t + 2) * kstep;
            const char* a3 = a2 + kstep; const char* b3 = b2 + kstep;
            if (last && has_next) S.a_ready(nxt);
            if constexpr (SP2) {
            PG8_LDB(B0, 0, 0); PG8_LDB(B1, 0, 1); PG8_SCHED; PG8_LDA(At, 0, 0); PG8_STAGE(PG8_SA(1, 1), a1 + hstepA, voffA);
            PG8_WAIT_V(8); PG8_WAIT_L(0); PG8_BAR; PG8_MMA(0, 0, At, B0); PG8_MMA(0, 1, At, B1); PG8_BAR; PG8_SCHED;
            PG8_LDA(At, 0, 1); PG8_STAGE(PG8_SB(0, 0), b2, voffB); PG8_STAGE(PG8_SB(0, 1), b2 + hstepB, voffB); PG8_STAGE(PG8_SA(0, 0), a2, voffA);
            PG8_WAIT_V(8); PG8_WAIT_L(0); PG8_BAR; PG8_MMA(1, 0, At, B0); PG8_MMA(1, 1, At, B1); PG8_BAR; PG8_SCHED;
            PG8_LDB(B0, 1, 0); PG8_LDB(B1, 1, 1); PG8_SCHED; PG8_LDA(At, 1, 0); PG8_STAGE(PG8_SA(0, 1), a2 + hstepA, voffA);
            PG8_WAIT_V(8); PG8_WAIT_L(0); PG8_BAR; PG8_MMA(0, 0, At, B0); PG8_MMA(0, 1, At, B1); PG8_BAR; PG8_SCHED;
            PG8_LDA(At, 1, 1); PG8_STAGE(PG8_SB(1, 0), b3, voffB); PG8_STAGE(PG8_SB(1, 1), b3 + hstepB, voffB); PG8_STAGE(PG8_SA(1, 0), a3, voffA);
            PG8_WAIT_V(8); PG8_WAIT_L(0); PG8_BAR; PG8_MMA(1, 0, At, B0); PG8_MMA(1, 1, At, B1); PG8_BAR; PG8_SCHED;
            } else {
            PG8_LDB(B0, 0, 0); PG8_SCHED; PG8_LDA(At, 0, 0); PG8_STAGE(PG8_SA(1, 1), a1 + hstepA, voffA);
            PG8_WAIT_L(8); PG8_BAR; PG8_WAIT_L(0); PG8_MMA(0, 0, At, B0); PG8_BAR; PG8_SCHED;
            PG8_LDB(B1, 0, 1); PG8_STAGE(PG8_SB(0, 0), b2, voffB);
            PG8_BAR; PG8_WAIT_L(0); PG8_MMA(0, 1, At, B1); PG8_BAR;
            PG8_LDA(At, 0, 1); PG8_STAGE(PG8_SA(0, 0), a2, voffA);
            PG8_BAR; PG8_WAIT_L(0); PG8_MMA(1, 0, At, B0); PG8_BAR; PG8_SCHED;
            PG8_STAGE(PG8_SB(0, 1), b2 + hstepB, voffB);
            PG8_WAIT_V(6); PG8_BAR; PG8_MMA(1, 1, At, B1); PG8_BAR;
            PG8_LDB(B0, 1, 0); PG8_SCHED; PG8_LDA(At, 1, 0); PG8_STAGE(PG8_SA(0, 1), a2 + hstepA, voffA);
            PG8_WAIT_L(8); PG8_BAR; PG8_WAIT_L(0); PG8_MMA(0, 0, At, B0); PG8_BAR; PG8_SCHED;
            PG8_LDB(B1, 1, 1); PG8_STAGE(PG8_SB(1, 0), b3, voffB);
            PG8_BAR; PG8_WAIT_L(0); PG8_MMA(0, 1, At, B1); PG8_BAR;
            PG8_LDA(At, 1, 1); PG8_STAGE(PG8_SA(1, 0), a3, voffA);
            PG8_BAR; PG8_WAIT_L(0); PG8_MMA(1, 0, At, B0); PG8_BAR; PG8_SCHED;
            PG8_STAGE(PG8_SB(1, 1), b3 + hstepB, voffB);
            PG8_WAIT_V(6); PG8_BAR; PG8_MMA(1, 1, At, B1); PG8_BAR;
            }
        }
        if constexpr (ALIGN_EPI) { if (wr == 0) PG8_BAR; }
        if constexpr (!Epi::AFTER_DRAIN) { E(acc, cur, wr, wc, fr, fq); S.done(cur); }
        if (!has_next) break;
#pragma unroll
        for (int a = 0; a < 2; ++a)
#pragma unroll
            for (int b = 0; b < 2; ++b)
#pragma unroll
                for (int m = 0; m < 4; ++m)
#pragma unroll
                    for (int n = 0; n < 2; ++n) acc[a][b][m][n] = (f32x4){0.f, 0.f, 0.f, 0.f};
        cur = nxt; cA = nA; cB = nB; ++ui;
        if constexpr (ALIGN_EPI) { if (wr == 1) PG8_BAR; }
    }
    PG8_WAIT_V(0);
    if constexpr (!ALIGN_EPI) { if (wr == 0) PG8_BAR; }
    PG8_BAR;
    if constexpr (Epi::AFTER_DRAIN) { E.fused(acc, cur, wr, wc, fr, fq, lds, wid, lane); S.done(cur); }
#undef PG8_KOFFA
#undef PG8_SA
#undef PG8_SB
#undef PG8_STAGE
#undef PG8_LDA
#undef PG8_LDB
#undef PG8_MMA
#undef PG8_WAIT_V
#undef PG8_WAIT_L
#undef PG8_BAR
#undef PG8_SCHED
}
}
namespace mix {
#define LAS __attribute__((address_space(3)))
typedef unsigned short bf16_t;
typedef short bf16x8 __attribute__((ext_vector_type(8)));
typedef short s16x4 __attribute__((ext_vector_type(4)));
typedef short v4i16_t __attribute__((ext_vector_type(4)));
typedef float f32x16 __attribute__((ext_vector_type(16)));
typedef float f32x4 __attribute__((ext_vector_type(4)));
typedef unsigned u32x4 __attribute__((ext_vector_type(4)));
typedef unsigned u32x2 __attribute__((ext_vector_type(2)));
typedef float f32x2_t __attribute__((ext_vector_type(2))); typedef __bf16 bf16x2_t __attribute__((ext_vector_type(2)));
constexpr int ZP = 3584, SEQ = 4096;
constexpr int KBUF = 32768;
constexpr int EXP = 132;
constexpr int QF_OFF = 98304;
constexpr int WSF_OFF = 131072;
constexpr float LOG2E = 1.4426950408889634f;
__device__ __forceinline__ int crow(int r, int hi) { return (r & 3) + 8 * (r >> 2) + 4 * hi; }
__device__ __forceinline__ unsigned cvtpk(float lo, float hi) { f32x2_t v = {lo, hi}; bf16x2_t b = __builtin_convertvector(v, bf16x2_t); return __builtin_bit_cast(unsigned, b); }
__device__ __forceinline__ float bf2f(unsigned short b) { return __uint_as_float((unsigned)b << 16); }
__device__ __forceinline__ float bflo(unsigned w) { return __uint_as_float(w << 16); }
__device__ __forceinline__ float bfhi(unsigned w) { return __uint_as_float(w & 0xffff0000u); }
__device__ __forceinline__ s16x4 vtr(const LAS unsigned char* p) { return __builtin_bit_cast(s16x4, __builtin_amdgcn_ds_read_tr16_b64_v4i16((LAS v4i16_t*)p)); }
__device__ __forceinline__ float swap32(float v) { auto rr = __builtin_amdgcn_permlane32_swap(__float_as_uint(v), __float_as_uint(v), false, false); return (__builtin_amdgcn_mbcnt_lo(~0u, 0u) & 32) ? __uint_as_float(rr[0]) : __uint_as_float(rr[1]); }
__device__ __forceinline__ float silu(float x) { return x * __builtin_amdgcn_rcpf(1.0f + __builtin_amdgcn_exp2f(-x * LOG2E)); }
__device__ __forceinline__ unsigned vtr_off(int lane, int cc, int t) {
    const int hi = lane >> 5, blk = (lane >> 4) & 1, q4 = (lane & 15) >> 2, p = lane & 3;
    return 256u * (4 * hi + 8 * t + q4) + 16u * (((cc ^ q4) << 2) | ((2 * blk + (p >> 1)) ^ (hi + 2 * t))) + 8u * (p & 1);
}
__device__ __forceinline__ void glds16(const void* gsrc, unsigned lds_dst) {
    asm volatile("s_mov_b32 m0, %1\n\ts_nop 0\n\tglobal_load_lds_dwordx4 %0, off" :: "v"(gsrc), "s"(lds_dst) : "memory", "m0"); }
__device__ __forceinline__ unsigned vst_off(int row, int ch) { return 256u * row + 16u * (ch ^ (((row & 3) << 2) | ((row >> 2) & 3))); }

__device__ __forceinline__ int att_tile(int i, int d0, int nl) { const int j = i - 2; const int tl = d0 - 1 - j, tr = d0 + i - nl; int t = (j < nl) ? tl : tr; t = (i < 2) ? d0 + i : t; return t; }
__device__ __forceinline__ void attn_unit(LAS unsigned char* lds, bf16_t* Z, int b, int h, int qb, float slope2, float lam, float oml, const float* subg, const int wave_in, const int W, const bool track, const bool first, const bool has_next, const int bN, const int hN, const int qbN, bool dry = false) {
    int tid_ = wave_in * 64 + lane_now(); asm volatile("" : "+v"(tid_));
    const int tid = tid_, lane = tid & 63, r32 = lane & 31, hi = lane >> 5; const int wid = __builtin_amdgcn_readfirstlane(tid >> 6);
    const int c = wid >> 2, qs = wid & 3;
    const size_t rowbase = (size_t)b * SEQ;
    bf16x8 qf[4];
    { const bf16_t* Qw = Z + (rowbase + qb * 128 + qs * 32 + r32) * ZP + h * 128 + c * 64 + hi * 8;
#pragma unroll
      for (int s = 0; s < 4; ++s) qf[s] = *(const bf16x8*)(Qw + s * 16); }
    const int vrow0 = 8 * wid + (lane >> 4), vrow1 = vrow0 + 4;
    const bf16_t* vg0 = Z + (rowbase + vrow0) * ZP + 1024 + h * 128 + ((lane & 15) ^ (((vrow0 & 3) << 2) | ((vrow0 >> 2) & 3))) * 8;
    const bf16_t* vg1 = Z + (rowbase + vrow1) * ZP + 1024 + h * 128 + ((lane & 15) ^ (((vrow1 & 3) << 2) | ((vrow1 >> 2) & 3))) * 8;
    const bf16_t* kg0 = vg0 - 512; const bf16_t* kg1 = vg1 - 512;
    unsigned kaddr[4], vaddr[4][2];
#pragma unroll
    for (int s = 0; s < 4; ++s) kaddr[s] = vst_off(r32, c * 8 + 2 * s + hi);
#pragma unroll
    for (int cc = 0; cc < 4; ++cc) { vaddr[cc][0] = 49152u + vtr_off(lane, cc, 0); vaddr[cc][1] = 49152u + vtr_off(lane, cc, 1); }
    LAS float* wsf = (LAS float*)(lds + WSF_OFF) + wid * 64;
    const unsigned lds0 = (unsigned)(uintptr_t)lds;
    const int q0w = qb * 128 + qs * 32, qpos = q0w + r32;
    bf16x8 kaug[2];
    { u32x4 w; w.y = hi ? 0x00003F80u : 0u; w.z = 0u; w.w = 0u;
      const unsigned k0b = __float_as_uint((float)r32) >> 16, k1b = __float_as_uint((float)(32 + r32)) >> 16;
      w.x = hi ? 0x3F803F80u : (k0b | (k0b << 16)); kaug[0] = __builtin_bit_cast(bf16x8, w);
      w.x = hi ? 0x3F803F80u : (k1b | (k1b << 16)); kaug[1] = __builtin_bit_cast(bf16x8, w); }
    unsigned slw;
    { const unsigned sh = cvtpk(slope2, 0.f) & 0xffffu; const float shf = __uint_as_float(sh << 16); const unsigned sl = cvtpk(slope2 - shf, 0.f) & 0xffffu; slw = sh | (sl << 16); }
    float lsum = 0.f;
    const int d0 = 2 * qb;
    float mhat = 0.f; f32x16 o[4]; const f32x16 zero16 = f32x16{};
#pragma unroll
    for (int cc = 0; cc < 4; ++cc) o[cc] = f32x16{};
    const int nl = (d0 < W) ? d0 : W, nr = (62 - d0 < W) ? 62 - d0 : W, NT = 2 + nl + nr;
#define ATT_TILE(i) att_tile((i), d0, nl)
#define ATT_DMAK_(k0p, k1p, tile, slot) do { const size_t go = (size_t)(tile) * 64 * ZP; const unsigned bb = lds0 + (slot) * 16384 + wid * 2048; \
        glds16((k0p) + go, (unsigned)__builtin_amdgcn_readfirstlane(bb)); glds16((k1p) + go, (unsigned)__builtin_amdgcn_readfirstlane(bb + 1024)); } while (0)
#define ATT_DMAK(tile, slot) ATT_DMAK_(kg0, kg1, tile, slot)
#define ATT_DMAV_(v0p, v1p, tile, slot) do { const size_t go = (size_t)(tile) * 64 * ZP; const unsigned bb = lds0 + 49152 + (slot) * 16384 + wid * 2048; \
        glds16((v0p) + go, (unsigned)__builtin_amdgcn_readfirstlane(bb)); glds16((v1p) + go, (unsigned)__builtin_amdgcn_readfirstlane(bb + 1024)); } while (0)
#define ATT_DMAV(tile, slot) ATT_DMAV_(vg0, vg1, tile, slot)
#define ATT_BAR() do { asm volatile("s_waitcnt vmcnt(0)" ::: "memory"); __syncthreads(); } while (0)
#define ATT_BAR4() do { asm volatile("s_waitcnt vmcnt(4)" ::: "memory"); __syncthreads(); } while (0)
#define MX3(a, b, c) __builtin_fmaxf(__builtin_fmaxf((a), (b)), (c))
#define ATT_QAUG(dst, kvs) do { const float sg_ = ((kvs) <= q0w) ? 1.0f : -1.0f; const float x_ = __builtin_fmaf(sg_ * slope2, (float)((tile_) * 64 - qpos), -mhat); \
        const unsigned wa_ = cvtpk(x_, x_); const float r1_ = x_ - __uint_as_float(wa_ & 0xffff0000u); const unsigned wb_ = cvtpk(r1_, r1_); const float r2_ = r1_ - __uint_as_float(wb_ & 0xffff0000u); \
        const unsigned wc_ = cvtpk(r2_, 0.f); u32x4 w_; w_.x = hi ? ((wa_ & 0xffffu) | (wb_ & 0xffff0000u)) : (((kvs) <= q0w) ? slw : (slw ^ 0x80008000u)); w_.y = hi ? wc_ : 0u; w_.z = 0u; w_.w = 0u; dst = __builtin_bit_cast(bf16x8, w_); } while (0)
#define ATT_QK(tile, kslot) do { const int tile_ = (tile); const LAS unsigned char* kb_ = lds + (kslot) * 16384; bf16x8 kf_[8]; \
        _Pragma("unroll") for (int s = 0; s < 4; ++s) { kf_[2 * s] = *(const LAS bf16x8*)(kb_ + kaddr[s]); kf_[2 * s + 1] = *(const LAS bf16x8*)(kb_ + kaddr[s] + 8192); } \
        bf16x8 qa0_, qa1_; ATT_QAUG(qa0_, tile_ * 64); ATT_QAUG(qa1_, tile_ * 64 + 32); \
        s0 = __builtin_amdgcn_mfma_f32_32x32x16_bf16(kaug[0], qa0_, zero16, 0, 0, 0); s1 = __builtin_amdgcn_mfma_f32_32x32x16_bf16(kaug[1], qa1_, zero16, 0, 0, 0); \
        _Pragma("unroll") for (int s = 0; s < 4; ++s) { s0 = __builtin_amdgcn_mfma_f32_32x32x16_bf16(kf_[2 * s], qf[s], s0, 0, 0, 0); s1 = __builtin_amdgcn_mfma_f32_32x32x16_bf16(kf_[2 * s + 1], qf[s], s1, 0, 0, 0); } \
        if (tile_ == d0 + (qs >> 1)) { const float m2_ = -2.0f * slope2; \
            if (qs & 1) { _Pragma("unroll") for (int r = 0; r < 16; ++r) s1[r] = __builtin_fmaf(m2_, __builtin_fmaxf((float)(crow(r, hi) - r32), 0.f), s1[r]); } \
            else { _Pragma("unroll") for (int r = 0; r < 16; ++r) s0[r] = __builtin_fmaf(m2_, __builtin_fmaxf((float)(crow(r, hi) - r32), 0.f), s0[r]); } } } while (0)
#define ATT_QK_OFF(tile, kslot) do { const int tile_ = (tile); const LAS unsigned char* kb_ = lds + (kslot) * 16384; bf16x8 kf_[8]; \
        _Pragma("unroll") for (int s = 0; s < 4; ++s) { kf_[2 * s] = *(const LAS bf16x8*)(kb_ + kaddr[s]); kf_[2 * s + 1] = *(const LAS bf16x8*)(kb_ + kaddr[s] + 8192); } \
        bf16x8 qa0_; ATT_QAUG(qa0_, tile_ * 64); \
        s0 = __builtin_amdgcn_mfma_f32_32x32x16_bf16(kaug[0], qa0_, zero16, 0, 0, 0); s1 = __builtin_amdgcn_mfma_f32_32x32x16_bf16(kaug[1], qa0_, zero16, 0, 0, 0); \
        _Pragma("unroll") for (int s = 0; s < 4; ++s) { s0 = __builtin_amdgcn_mfma_f32_32x32x16_bf16(kf_[2 * s], qf[s], s0, 0, 0, 0); s1 = __builtin_amdgcn_mfma_f32_32x32x16_bf16(kf_[2 * s + 1], qf[s], s1, 0, 0, 0); } } while (0)
#define ATT_ROWMAX(rm) do { float a_ = MX3(s0[0], s0[1], s1[0]), b_ = MX3(s0[2], s0[3], s1[1]); a_ = MX3(a_, s1[2], s1[3]); \
        _Pragma("unroll") for (int r = 4; r < 16; r += 4) { a_ = MX3(a_, s0[r], s0[r + 1]); b_ = MX3(b_, s0[r + 2], s0[r + 3]); a_ = MX3(a_, s1[r], s1[r + 1]); b_ = MX3(b_, s1[r + 2], s1[r + 3]); } \
        rm = __builtin_fmaxf(a_, b_); rm = __builtin_fmaxf(rm, swap32(rm)); } while (0)
#define ATT_RESC_CHECK(rm) do { if (__any(rm > 8.0f)) { const float dl = __builtin_fmaxf(rm, 0.f); mhat += dl; \
        _Pragma("unroll") for (int r = 0; r < 16; ++r) { s0[r] -= dl; s1[r] -= dl; } \
        const float f = __builtin_amdgcn_exp2f(-dl); lsum *= f; wsf[r32] = f; resc = true; } } while (0)
#define ATT_EXP_PACK() do { float sa_ = 0.f, sb_ = 0.f; \
        _Pragma("unroll") for (int r = 0; r < 16; ++r) { s0[r] = __builtin_amdgcn_exp2f(s0[r]); s1[r] = __builtin_amdgcn_exp2f(s1[r]); sa_ += s0[r]; sb_ += s1[r]; } \
        lsum += sa_ + sb_; u32x4 w; \
        w.x = cvtpk(s0[0], s0[1]); w.y = cvtpk(s0[2], s0[3]); w.z = cvtpk(s0[4], s0[5]); w.w = cvtpk(s0[6], s0[7]); pf[0] = __builtin_bit_cast(bf16x8, w); \
        w.x = cvtpk(s0[8], s0[9]); w.y = cvtpk(s0[10], s0[11]); w.z = cvtpk(s0[12], s0[13]); w.w = cvtpk(s0[14], s0[15]); pf[1] = __builtin_bit_cast(bf16x8, w); \
        w.x = cvtpk(s1[0], s1[1]); w.y = cvtpk(s1[2], s1[3]); w.z = cvtpk(s1[4], s1[5]); w.w = cvtpk(s1[6], s1[7]); pf[2] = __builtin_bit_cast(bf16x8, w); \
        w.x = cvtpk(s1[8], s1[9]); w.y = cvtpk(s1[10], s1[11]); w.z = cvtpk(s1[12], s1[13]); w.w = cvtpk(s1[14], s1[15]); pf[3] = __builtin_bit_cast(bf16x8, w); } while (0)
#define ATT_RESC_APPLY() do { if (resc) { asm volatile("s_waitcnt lgkmcnt(0)" ::: "memory"); __builtin_amdgcn_wave_barrier(); \
        _Pragma("unroll") for (int k = 0; k < 4; ++k) { const f32x4 fv_ = *(const LAS f32x4*)(wsf + 8 * k + 4 * hi); \
            _Pragma("unroll") for (int cc = 0; cc < 4; ++cc) { o[cc][4 * k + 0] *= fv_[0]; o[cc][4 * k + 1] *= fv_[1]; o[cc][4 * k + 2] *= fv_[2]; o[cc][4 * k + 3] *= fv_[3]; } \
            } \
        asm volatile("s_waitcnt lgkmcnt(0)" ::: "memory"); __builtin_amdgcn_wave_barrier(); } } while (0)
#define ATT_VRD(dst, vb_, cc) do { _Pragma("unroll") for (int ks = 0; ks < 4; ++ks) { dst[2 * ks] = vtr(vb_ + vaddr[cc][0] + ks * 4096); dst[2 * ks + 1] = vtr(vb_ + vaddr[cc][1] + ks * 4096); } } while (0)
#define ATT_VF(src, ks) (bf16x8){src[2 * (ks)][0], src[2 * (ks)][1], src[2 * (ks)][2], src[2 * (ks)][3], src[2 * (ks) + 1][0], src[2 * (ks) + 1][1], src[2 * (ks) + 1][2], src[2 * (ks) + 1][3]}
#define ATT_PV(cc, src) do { _Pragma("unroll") for (int ks = 0; ks < 4; ++ks) o[cc] = __builtin_amdgcn_mfma_f32_32x32x16_bf16(pf[ks], ATT_VF(src, ks), o[cc], 0, 0, 0); } while (0)
    f32x16 s0, s1; bf16x8 pf[4]; bool resc = false;
    f32x4 fv[4];
    if (c == 0) __builtin_amdgcn_s_setprio(1);
    {
        if (first) { ATT_DMAK(ATT_TILE(0), 0); ATT_DMAV(ATT_TILE(0), 0); ATT_DMAK(ATT_TILE(1), 1); }
        { const int i2 = (2 < NT) ? 2 : NT - 1; const int t2 = ATT_TILE(i2); ATT_DMAK(t2, 2); ATT_DMAV(ATT_TILE(1), 1); } }
    ATT_BAR4();
    { ATT_QK(ATT_TILE(0), 0); if (track) { float rm; ATT_ROWMAX(rm); ATT_RESC_CHECK(rm); } ATT_EXP_PACK(); resc = false; }
    ATT_BAR();
#define ATT_PVC(cc, src) do { _Pragma("unroll") for (int ks = 0; ks < 4; ++ks) o[cc] = __builtin_amdgcn_mfma_f32_32x32x16_bf16(pc[ks], ATT_VF(src, ks), o[cc], 0, 0, 0); } while (0)
#define ATT_LSUM() do { } while (0)
    int m3 = 0;
    {
        const int i = 0;
        const int m3p1 = (m3 == 2) ? 0 : m3 + 1, m3p2 = (m3 == 0) ? 2 : m3 - 1;
        { const int i3 = __builtin_elementwise_min(i + 3, NT - 1); const int t3 = ATT_TILE(i3); ATT_DMAK(t3, m3); }
        { const int i2 = __builtin_elementwise_min(i + 2, NT - 1); const int t2 = ATT_TILE(i2); ATT_DMAV(t2, m3p2); }
        const int t1 = ATT_TILE(i + 1);
        const LAS unsigned char* vb = lds + m3 * 16384;
        s16x4 va[8], vbb[8];
        bf16x8 pc[4];
#pragma unroll
        for (int k = 0; k < 4; ++k) pc[k] = pf[k];
        ATT_VRD(va, vb, 0);
        ATT_QK(t1, m3p1);
        ATT_VRD(vbb, vb, 1);
        if (track) { float rm; ATT_ROWMAX(rm); ATT_RESC_CHECK(rm); }
        ATT_PVC(0, va);
        ATT_VRD(va, vb, 2);
        ATT_PVC(1, vbb);
        ATT_VRD(vbb, vb, 3);
        ATT_EXP_PACK();
        ATT_PVC(2, va);
        ATT_LSUM();
        ATT_PVC(3, vbb);
        asm volatile("" : "+v"(pf[0]), "+v"(pf[1]), "+v"(pf[2]), "+v"(pf[3]));
#pragma unroll
        for (int g_ = 0; g_ < 16; ++g_) { __builtin_amdgcn_sched_group_barrier(0x008, 1, 0); __builtin_amdgcn_sched_group_barrier(0x002, 3, 0); __builtin_amdgcn_sched_group_barrier(0x100, 1, 0); }
        if (track) { ATT_RESC_APPLY(); resc = false; }
        ATT_BAR4();
        m3 = m3p1;
    }
    for (int i = 1; i < NT - 1; ++i) {
        const int m3p1 = (m3 == 2) ? 0 : m3 + 1, m3p2 = (m3 == 0) ? 2 : m3 - 1;
        { const int i3 = __builtin_elementwise_min(i + 3, NT - 1); const int t3 = ATT_TILE(i3); ATT_DMAK(t3, m3); }
        { const int i2 = __builtin_elementwise_min(i + 2, NT - 1); const int t2 = ATT_TILE(i2); ATT_DMAV(t2, m3p2); }
        const int t1 = ATT_TILE(i + 1);
        const LAS unsigned char* vb = lds + m3 * 16384;
        s16x4 va[8], vbb[8];
        bf16x8 pc[4];
#pragma unroll
        for (int k = 0; k < 4; ++k) pc[k] = pf[k];
        ATT_VRD(va, vb, 0);
        ATT_QK_OFF(t1, m3p1);
        ATT_VRD(vbb, vb, 1);
        if (track) { float rm; ATT_ROWMAX(rm); ATT_RESC_CHECK(rm); }
        ATT_PVC(0, va);
        ATT_VRD(va, vb, 2);
        ATT_PVC(1, vbb);
        ATT_VRD(vbb, vb, 3);
        ATT_EXP_PACK();
        ATT_PVC(2, va);
        ATT_LSUM();
        ATT_PVC(3, vbb);
        asm volatile("" : "+v"(pf[0]), "+v"(pf[1]), "+v"(pf[2]), "+v"(pf[3]));
#pragma unroll
        for (int g_ = 0; g_ < 16; ++g_) { __builtin_amdgcn_sched_group_barrier(0x008, 1, 0); __builtin_amdgcn_sched_group_barrier(0x002, 3, 0); __builtin_amdgcn_sched_group_barrier(0x100, 1, 0); }
        if (track) { ATT_RESC_APPLY(); resc = false; }
        ATT_BAR4();
        m3 = m3p1;
    }
    {
        const LAS unsigned char* vb = lds + m3 * 16384;
        s16x4 va[8], vbb[8]; bf16x8 pc[4];
#pragma unroll
        for (int k = 0; k < 4; ++k) pc[k] = pf[k];
        ATT_VRD(va, vb, 0); ATT_VRD(vbb, vb, 1); ATT_PVC(0, va); ATT_VRD(va, vb, 2); ATT_PVC(1, vbb); ATT_VRD(vbb, vb, 3); ATT_PVC(2, va); ATT_LSUM(); ATT_PVC(3, vbb);
        { const float lt = lsum + swap32(lsum); const float fac = ((c == 0) ? 1.0f : -lam) * __builtin_amdgcn_rcpf(lt);
          wsf[r32] = fac; asm volatile("s_waitcnt lgkmcnt(0)" ::: "memory"); __builtin_amdgcn_wave_barrier();
#pragma unroll
          for (int k = 0; k < 4; ++k) fv[k] = *(const LAS f32x4*)(wsf + 8 * k + 4 * hi);
          asm volatile("s_waitcnt lgkmcnt(0)" ::: "memory"); }
        ATT_BAR();
    }
    __builtin_amdgcn_s_setprio(0);
    if (has_next) {
        const size_t rbN = (size_t)bN * SEQ; const int d0N = 2 * qbN;
        const bf16_t* vgN0 = Z + (rbN + vrow0) * ZP + 1024 + hN * 128 + ((lane & 15) ^ (((vrow0 & 3) << 2) | ((vrow0 >> 2) & 3))) * 8;
        const bf16_t* vgN1 = Z + (rbN + vrow1) * ZP + 1024 + hN * 128 + ((lane & 15) ^ (((vrow1 & 3) << 2) | ((vrow1 >> 2) & 3))) * 8;
        ATT_DMAK_(vgN0 - 512, vgN1 - 512, d0N, 0); ATT_DMAV_(vgN0, vgN1, d0N, 0); ATT_DMAK_(vgN0 - 512, vgN1 - 512, d0N + 1, 1);
    }
#undef ATT_TILE
#undef ATT_DMAK
#undef ATT_DMAK_
#undef ATT_DMAV_
#undef ATT_BAR
#undef ATT_BAR4
#undef ATT_DMAV
#undef ATT_QK
#undef ATT_QK_OFF
#undef ATT_ROWMAX
#undef ATT_RESC_CHECK
#undef ATT_EXP_PACK
#undef ATT_RESC_APPLY
#undef ATT_VRD
#undef ATT_VF
#undef ATT_PV
#undef ATT_PVC
#undef ATT_LSUM
#undef ATT_QAUG
#undef MX3
    u32x2 gpre[8];
#pragma unroll
    for (int it = 0; it < 8; ++it) gpre[it] = *(const u32x2*)(Z + (rowbase + qb * 128 + wid * 16 + 2 * it + hi) * ZP + h * 128 + 4 * r32 + 1536);
    LAS float* Ex = (LAS float*)(lds + 65536);
    if (c == 1) {
#pragma unroll
        for (int cc = 0; cc < 4; ++cc)
#pragma unroll
            for (int r = 0; r < 16; ++r) Ex[(qs * 32 + crow(r, hi)) * EXP + cc * 32 + r32] = o[cc][r] * fv[r >> 2][r & 3];
    }
    __syncthreads();
    if (c == 0) {
        float ex_[4][16];
#pragma unroll
        for (int cc = 0; cc < 4; ++cc)
#pragma unroll
            for (int r = 0; r < 16; ++r) ex_[cc][r] = Ex[(qs * 32 + crow(r, hi)) * EXP + cc * 32 + r32];
        asm volatile("" ::: "memory");
#pragma unroll
        for (int cc = 0; cc < 4; ++cc)
#pragma unroll
            for (int r = 0; r < 16; ++r) Ex[(qs * 32 + crow(r, hi)) * EXP + cc * 32 + r32] = ex_[cc][r] + o[cc][r] * fv[r >> 2][r & 3];
    }
    __syncthreads();
    { const f32x4 sg = *(const f32x4*)(subg + 4 * r32);
#pragma unroll
      for (int it = 0; it < 8; ++it) { const int row = wid * 16 + 2 * it + hi;
        const f32x4 v = *(const LAS f32x4*)(Ex + row * EXP + 4 * r32);
        float ss = (v[0] * v[0] + v[1] * v[1]) + (v[2] * v[2] + v[3] * v[3]);
        ss += __shfl_xor(ss, 1); ss += __shfl_xor(ss, 2); ss += __shfl_xor(ss, 4); ss += __shfl_xor(ss, 8); ss += __shfl_xor(ss, 16);
        const float rs = __builtin_amdgcn_rsqf(ss * (1.0f / 128.0f) + 1e-6f) * oml;
        bf16_t* zr = Z + (rowbase + qb * 128 + row) * ZP + h * 128 + 4 * r32;
        const u32x2 gw = gpre[it];
        const float o0 = v[0] * rs * sg[0] * silu(bflo(gw.x)), o1 = v[1] * rs * sg[1] * silu(bfhi(gw.x)), o2 = v[2] * rs * sg[2] * silu(bflo(gw.y)), o3 = v[3] * rs * sg[3] * silu(bfhi(gw.y));
        u32x2 ow; ow.x = cvtpk(o0, o1); ow.y = cvtpk(o2, o3); if (!dry) *(u32x2*)zr = ow; } }
    __syncthreads();
}

__device__ __forceinline__ void sgu_unit(LAS unsigned char* lds, bf16_t* Z, int b, int chunk, const float* vng, const bf16_t* Wsb, const float* bs, const int wave_in, bool dry = false) {
    int tid_ = wave_in * 64 + lane_now(); asm volatile("" : "+v"(tid_));
    const int tid = tid_, lane = tid & 63, r32 = lane & 31, hi = lane >> 5; const int wid = __builtin_amdgcn_readfirstlane(tid >> 6);
    const size_t rowbase = (size_t)b * SEQ + (size_t)chunk * 128;
    { f32x4 g0 = *(const f32x4*)(vng + lane * 8), g1 = *(const f32x4*)(vng + lane * 8 + 4);
#pragma unroll 8
      for (int it = 0; it < 16; ++it) { const int row = wid * 16 + it;
        const u32x4 raw = *(const u32x4*)(Z + (rowbase + row) * ZP + 2560 + lane * 8);
        float x[8] = {bflo(raw.x), bfhi(raw.x), bflo(raw.y), bfhi(raw.y), bflo(raw.z), bfhi(raw.z), bflo(raw.w), bfhi(raw.w)};
        float ss = 0.f;
#pragma unroll
        for (int j = 0; j < 8; ++j) ss += x[j] * x[j];
#pragma unroll
        for (int of = 1; of < 64; of <<= 1) ss += __shfl_xor(ss, of);
        const float rs = __builtin_amdgcn_rsqf(ss * (1.0f / 512.0f) + 1e-6f);
        u32x4 w; w.x = cvtpk(x[0] * rs * g0[0], x[1] * rs * g0[1]); w.y = cvtpk(x[2] * rs * g0[2], x[3] * rs * g0[3]); w.z = cvtpk(x[4] * rs * g1[0], x[5] * rs * g1[1]); w.w = cvtpk(x[6] * rs * g1[2], x[7] * rs * g1[3]);
        *(LAS u32x4*)(lds + (lane >> 4) * 32768 + vst_off(row, lane & 15)) = w; } }
    __syncthreads();
    const int tb = wid & 3, dh = wid >> 2;
    unsigned va[2][2];
#pragma unroll
    for (int c2 = 0; c2 < 2; ++c2) { va[c2][0] = vtr_off(lane, dh * 2 + c2, 0); va[c2][1] = vtr_off(lane, dh * 2 + c2, 1); }
    for (int g = 0; g < 4; ++g) {
        bf16x8 af[8];
        { const bf16_t* wp = Wsb + ((size_t)(g * 128 + tb * 32 + r32)) * 128 + 4 * hi;
#pragma unroll
          for (int ks = 0; ks < 8; ++ks) { const u32x2 lo = *(const u32x2*)(wp + 16 * ks), hh = *(const u32x2*)(wp + 16 * ks + 8); u32x4 w; w.x = lo.x; w.y = lo.y; w.z = hh.x; w.w = hh.y; af[ks] = __builtin_bit_cast(bf16x8, w); } }
        f32x16 acc[2]; acc[0] = f32x16{}; acc[1] = f32x16{};
        const LAS unsigned char* tbp = lds + g * 32768;
#pragma unroll
        for (int c2 = 0; c2 < 2; ++c2)
#pragma unroll
            for (int ks = 0; ks < 8; ++ks) { const s16x4 lo = vtr(tbp + va[c2][0] + ks * 4096), hh = vtr(tbp + va[c2][1] + ks * 4096);
                const bf16x8 vf = (bf16x8){lo[0], lo[1], lo[2], lo[3], hh[0], hh[1], hh[2], hh[3]};
                acc[c2] = __builtin_amdgcn_mfma_f32_32x32x16_bf16(af[ks], vf, acc[c2], 0, 0, 0); }
        unsigned short uu_[2][16], gg_[2][16];
#pragma unroll
        for (int c2 = 0; c2 < 2; ++c2)
#pragma unroll
            for (int r = 0; r < 16; ++r) { const int t = tb * 32 + crow(r, hi); const int col = g * 128 + (dh * 2 + c2) * 32 + r32;
                const bf16_t* zp = Z + (rowbase + t) * ZP + 2048 + col; uu_[c2][r] = zp[0]; gg_[c2][r] = zp[1024]; }
#pragma unroll
        for (int c2 = 0; c2 < 2; ++c2)
#pragma unroll
            for (int r = 0; r < 16; ++r) { const int t = tb * 32 + crow(r, hi); const int col = g * 128 + (dh * 2 + c2) * 32 + r32;
                bf16_t* zp = Z + (rowbase + t) * ZP + 2048 + col;
                const float sv = acc[c2][r] + bs[g * 128 + t];
                const float ov = bf2f(uu_[c2][r]) * sv * silu(bf2f(gg_[c2][r]));
                if (!dry) zp[0] = (bf16_t)(cvtpk(ov, 0.f) & 0xffffu); }
    }
    __syncthreads();
}
#undef LAS
}
#define LAS __attribute__((address_space(3)))
typedef unsigned short bf16;
typedef unsigned v4u __attribute__((ext_vector_type(4)));
typedef float f32x4 __attribute__((ext_vector_type(4)));
constexpr int NWAVES = 8, NTHREADS = 512;
constexpr int DM = 1024, DIN = 3584, DEPTH = 4, SEQ = 4096, NB_P = 8, NB_S = 16, NB = 24;
constexpr int M = NB * SEQ;
constexpr int M_P = NB_P * SEQ;
constexpr size_t MiB = 1u << 20;
constexpr size_t WS_MISC = 0;
constexpr size_t WS_HMAX = 65536;
constexpr size_t WS_WIN = 1 * MiB;
constexpr size_t WS_WOUT = 30 * MiB;
constexpr size_t WS_WS = 39 * MiB;
constexpr size_t WS_SSQ = 40 * MiB;
constexpr size_t WS_XB = 44 * MiB;
constexpr size_t WS_Z = 240 * MiB;
constexpr size_t WS_END = WS_Z + (size_t)M * DIN * 2;
static_assert(WS_XB + (size_t)M * DM * 2 <= WS_Z && WS_END <= (size_t)1024 * MiB, "d_ws map");
constexpr int LDS_BYTES = 139264;

__device__ __forceinline__ unsigned f2bf(float f) { unsigned u = __builtin_bit_cast(unsigned, f); return (u + 0x7fffu + ((u >> 16) & 1u)) >> 16; }
__device__ __forceinline__ unsigned pk2(float lo, float hi) { return f2bf(lo) | (f2bf(hi) << 16); }
__device__ __forceinline__ float wave_sum(float v) {
#pragma unroll
    for (int o = 1; o < 64; o <<= 1) v += __shfl_xor(v, o);
    return v;
}
__device__ __forceinline__ void transpose_item(const float* W, int K, int N, bf16* WT, const float* gsc, LAS float* scr, int item, int lane) {
    const int nblk = N / 32, kb = item / nblk, nb = item % nblk, k0 = 64 * kb, n0 = 32 * nb;
#pragma unroll 8
    for (int i = 0; i < 32; ++i) { const int kk = 2 * i + (lane >> 5); const float sc = gsc ? gsc[k0 + kk] : 1.0f; scr[kk * 33 + (lane & 31)] = W[(size_t)(k0 + kk) * N + n0 + (lane & 31)] * sc; }
    asm volatile("s_waitcnt lgkmcnt(0)" ::: "memory");
    const int c = lane & 7;
#pragma unroll
    for (int j = 0; j < 4; ++j) { const int n = (lane >> 3) + 8 * j; const LAS float* s = scr + (8 * c) * 33 + n;
        v4u o; o.x = pk2(s[0 * 33], s[1 * 33]); o.y = pk2(s[2 * 33], s[3 * 33]); o.z = pk2(s[4 * 33], s[5 * 33]); o.w = pk2(s[6 * 33], s[7 * 33]);
        *(v4u*)(WT + (size_t)(n0 + n) * K + k0 + 8 * c) = o; }
    asm volatile("s_waitcnt lgkmcnt(0)" ::: "memory");
}

struct Args { const float* xp; const float* xs; const float* norm_g; const float* w_in; const float* lambda_qk; const float* subln_g; const float* vnorm_g;
              const float* w_s; const float* b_s; const float* w_out; const float* final_g; float* out; unsigned char* ws; };

__global__ void __launch_bounds__(NTHREADS) hymba_fwd(Args a) {
    extern __shared__ __attribute__((aligned(16))) unsigned char lds_raw[];
    LAS unsigned char* lds = (LAS unsigned char*)lds_raw;
    cg::grid_group grid = cg::this_grid();
    const int tid = threadIdx.x, lane = tid & 63; const int wave = __builtin_amdgcn_readfirstlane(tid >> 6);
    const int G = gridDim.x, bx = blockIdx.x;
    const int vcu = (G % 8 == 0) ? (bx % 8) * (G / 8) + bx / 8 : bx;
    unsigned char* ws = a.ws;
    float* misc = (float*)(ws + WS_MISC);
    unsigned* hmax = (unsigned*)(ws + WS_HMAX);
    bf16* WinT = (bf16*)(ws + WS_WIN); bf16* WoutT = (bf16*)(ws + WS_WOUT); bf16* Wsb = (bf16*)(ws + WS_WS);
    unsigned long long* ssq = (unsigned long long*)(ws + WS_SSQ);
    bf16* XB = (bf16*)(ws + WS_XB); bf16* Z = (bf16*)(ws + WS_Z);

    {
        const int gw = vcu * NWAVES + wave, NGW = G * NWAVES;
        LAS float* scr = (LAS float*)(lds + wave * 16384);
        constexpr int I_IN = (DM / 64) * (DIN / 32), I_OUT = (DM / 64) * (DM / 32), I_L = I_IN + I_OUT;
        for (int it = gw; it < DEPTH * I_L; it += NGW) { const int l = it / I_L; int r = it % I_L;
            if (r < I_IN) transpose_item(a.w_in + (size_t)l * DM * DIN, DM, DIN, WinT + (size_t)l * DIN * DM, a.norm_g + l * DM, scr, r, lane);
            else transpose_item(a.w_out + (size_t)l * DM * DM, DM, DM, WoutT + (size_t)l * DM * DM, nullptr, scr, r - I_IN, lane); }
        for (int i = (bx * NTHREADS + tid); i < DEPTH * 4 * 128 * 128 / 2; i += G * NTHREADS) { const float2 v = ((const float2*)a.w_s)[i]; ((unsigned*)Wsb)[i] = pk2(v.x, v.y); }
        for (int i = (bx * NTHREADS + tid); i < 4 * M; i += G * NTHREADS) ssq[M + i] = 0ull;
        for (int i = (bx * NTHREADS + tid); i < DEPTH * NB * 32; i += G * NTHREADS) hmax[i] = 0u;
        for (int m0 = gw; m0 < M; m0 += 4 * NGW) {
            f32x4 v[4][4];
#pragma unroll
            for (int q = 0; q < 4; ++q) { const int m = m0 + q * NGW; if (m < M) { const float* xr = (m < M_P) ? a.xp + (size_t)m * DM : a.xs + (size_t)(m - M_P) * DM; const f32x4* x4 = (const f32x4*)xr + lane;
#pragma unroll
                for (int j = 0; j < 4; ++j) v[q][j] = x4[64 * j]; } }
#pragma unroll
            for (int q = 0; q < 4; ++q) { const int m = m0 + q * NGW; if (m < M) { float s = 0.f;
#pragma unroll
                for (int j = 0; j < 4; ++j) s += (v[q][j].x * v[q][j].x + v[q][j].y * v[q][j].y) + (v[q][j].z * v[q][j].z + v[q][j].w * v[q][j].w);
                s = wave_sum(s);
                if (lane == 0) ssq[m] = (unsigned long long)(s * pg8::SSQ_SCALE);
                unsigned long long* o8 = (unsigned long long*)(XB + (size_t)m * DM) + lane;
#pragma unroll
                for (int j = 0; j < 4; ++j) o8[64 * j] = (unsigned long long)pk2(v[q][j].x, v[q][j].y) | ((unsigned long long)pk2(v[q][j].z, v[q][j].w) << 32); } }
        }
        if (bx == 0 && wave == 0) {
            for (int l = 0; l < DEPTH; ++l) { const float* lq = a.lambda_qk + l * 256;
                const float s1 = wave_sum(lq[lane] * lq[64 + lane]), s2 = wave_sum(lq[128 + lane] * lq[192 + lane]);
                const float li = 0.8f - 0.6f * expf(-0.3f * (float)l);
                if (lane == 0) { misc[2 * l] = expf(s1) - expf(s2) + li; misc[2 * l + 1] = li; } }
        }
    }
    grid.sync();

    for (int l = 0; l < DEPTH; ++l) {
        {
            pg8::Gemm g{XB, WinT + (size_t)l * DIN * DM, M, DIN, DM, DM, 0}; pg8::StaticOrder S; S.init(M, DIN, G, bx);
            pg8::EpiZ E{Z, ssq + (size_t)l * M, 0.125f * 1.4426950408889634f, hmax + l * NB * 32};
#ifndef NO_GEMM1
            pg8::gemm_phase<pg8::EpiZ, pg8::StaticOrder, true, true>(lds, g, S, E, wave);
#endif
#ifdef PROBE_GEMM1X2
            grid.sync();
#ifdef PROBE_SYNC2
        grid.sync(); grid.sync(); grid.sync(); grid.sync();
#endif
            pg8::gemm_phase<pg8::EpiZ, pg8::StaticOrder, true, true>(lds, g, S, E, wave);
#endif
        }
        grid.sync();
#ifdef PROBE_SYNC2
        grid.sync(); grid.sync(); grid.sync(); grid.sync();
#endif
        {
            const float lam = __uint_as_float(__builtin_amdgcn_readfirstlane(__float_as_uint(misc[2 * l]))), li = __uint_as_float(__builtin_amdgcn_readfirstlane(__float_as_uint(misc[2 * l + 1])));
            const unsigned* hmaxL = hmax + l * NB * 32;
            const int nper = G / 8, xcd = vcu / nper, slot = vcu % nper;
#ifndef NO_ATT
            const int nunits = (G == 256) ? 12 : (NB * 4 * 32 - bx + G - 1) / G;
            LAS int* wtab = (LAS int*)(lds + LDS_BYTES - 512);
            if (G == 256 && tid < 12) { const int i = tid; const int pair = i * 8 + ((xcd + i) & 7); const int b = pair >> 2, h = pair & 3;
                const float slope2 = exp2f(-2.0f * (float)(h + 1)) * 1.4426950408889634f;
                const unsigned* hp = hmaxL + b * 32 + h * 4; float R2 = 0.f;
                for (int c = 0; c < 2; ++c) { const float q2 = __uint_as_float(hp[2 * c]) + __uint_as_float(hp[2 * c + 1]); const float k2 = __uint_as_float(hp[16 + 2 * c]) + __uint_as_float(hp[16 + 2 * c + 1]); R2 = fmaxf(R2, q2 * k2); }
                const float R = sqrtf(R2) * 1.02f + 0.5f; const float dd = (160.0f + 2.0f * R) / slope2;
                const float wf = floorf((dd - 1.0f) * (1.0f / 64.0f)) + 1.0f;
                wtab[2 * i] = (wf >= 62.0f) ? 62 : (wf < 0.f ? 0 : (int)wf); wtab[2 * i + 1] = (R <= 48.0f) ? 0 : 1; }
            __syncthreads();
            for (int i = 0; i < nunits; ++i) { int pair, qb, pairN, qbN;
                if (G == 256) { pair = i * 8 + ((xcd + i) & 7); qb = (slot + 11 * i) & 31; pairN = (i + 1) * 8 + ((xcd + i + 1) & 7); qbN = (slot + 11 * (i + 1)) & 31; }
                else { const int u = bx + i * G; pair = u >> 5; qb = u & 31; pairN = (u + G) >> 5; qbN = (u + G) & 31; }
                const int b = pair >> 2, h = pair & 3;
                const float slope2 = exp2f(-2.0f * (float)(h + 1)) * 1.4426950408889634f;
                int W; float Rg;
                if (G == 256) { W = __builtin_amdgcn_readfirstlane(wtab[2 * i]); Rg = __builtin_amdgcn_readfirstlane(wtab[2 * i + 1]) ? 1000.0f : 0.0f; }
                else { const unsigned* hp = hmaxL + b * 32 + h * 4; float R2 = 0.f;
                  for (int c = 0; c < 2; ++c) { const float q2 = __uint_as_float(__builtin_amdgcn_readfirstlane(hp[2 * c])) + __uint_as_float(__builtin_amdgcn_readfirstlane(hp[2 * c + 1]));
                      const float k2 = __uint_as_float(__builtin_amdgcn_readfirstlane(hp[16 + 2 * c])) + __uint_as_float(__builtin_amdgcn_readfirstlane(hp[16 + 2 * c + 1])); R2 = fmaxf(R2, q2 * k2); }
                  const float R = sqrtf(R2) * 1.02f + 0.5f; Rg = R; const float dd = (160.0f + 2.0f * R) / slope2;
                  const float wf = floorf((dd - 1.0f) * (1.0f / 64.0f)) + 1.0f; W = (wf >= 62.0f) ? 62 : (wf < 0.f ? 0 : (int)wf); }
                const bool track = !(Rg <= 48.0f);
                mix::attn_unit(lds, Z, b, h, qb, slope2, lam, 1.0f - li, a.subln_g + l * 128, wave, W, track, i == 0, i + 1 < nunits, pairN >> 2, pairN & 3, qbN); }
#endif
#ifndef NO_SGU
#ifdef PROBE_SGU2
            for (int u = bx; u < NB * 32; u += G)
                mix::sgu_unit(lds, Z, u >> 5, u & 31, a.vnorm_g + l * 512, Wsb + (size_t)l * 4 * 128 * 128, a.b_s + l * 512, wave, true);
#endif
            for (int u = bx; u < NB * 32; u += G)
                mix::sgu_unit(lds, Z, u >> 5, u & 31, a.vnorm_g + l * 512, Wsb + (size_t)l * 4 * 128 * 128, a.b_s + l * 512, wave);
#endif
        }
        grid.sync();
#ifdef PROBE_SYNC2
        grid.sync(); grid.sync(); grid.sync(); grid.sync();
#endif
        {
            pg8::Gemm g{Z, WoutT + (size_t)l * DM * DM, M, DM, DM, DIN, 3072}; pg8::StaticOrder S; S.init(M, DM, G, bx);
            pg8::EpiRes E{XB, ssq + (size_t)(l + 1) * M, false};
#ifdef PROBE_GEMM2X2
            { pg8::EpiRes E2 = E; E2.dry = true; pg8::gemm_phase<pg8::EpiRes, pg8::StaticOrder, true, true>(lds, g, S, E2, wave); grid.sync(); }
#endif
#ifndef NO_GEMM2
            pg8::gemm_phase<pg8::EpiRes, pg8::StaticOrder, true, true>(lds, g, S, E, wave);
#endif
        }
        grid.sync();
#ifdef PROBE_SYNC2
        grid.sync(); grid.sync(); grid.sync(); grid.sync();
#endif
    }
    {
        int lane_ = lane_now(); asm volatile("" : "+v"(lane_)); const int lane = lane_;
        const int gw = vcu * NWAVES + wave, NGW = G * NWAVES;
        const f32x4* g4 = (const f32x4*)a.final_g + lane; f32x4 gv[4];
#pragma unroll
        for (int j = 0; j < 4; ++j) gv[j] = g4[64 * j];
        for (int m0 = gw; m0 < M; m0 += 4 * NGW) {
            unsigned long long w[4][4]; unsigned long long sq[4];
#pragma unroll
            for (int q = 0; q < 4; ++q) { const int m = m0 + q * NGW; if (m < M) { sq[q] = ssq[(size_t)4 * M + m]; const unsigned long long* xr = (const unsigned long long*)(XB + (size_t)m * DM) + lane;
#pragma unroll
                for (int j = 0; j < 4; ++j) w[q][j] = xr[64 * j]; } }
#pragma unroll
            for (int q = 0; q < 4; ++q) { const int m = m0 + q * NGW; if (m < M) {
                const float rs = __builtin_amdgcn_rsqf((float)sq[q] * (pg8::SSQ_INV / 1024.0f) + 1e-6f);
                f32x4* o4 = (f32x4*)(a.out + (size_t)m * DM) + lane;
#pragma unroll
                for (int j = 0; j < 4; ++j) { const unsigned lo = (unsigned)w[q][j], hi = (unsigned)(w[q][j] >> 32);
                    f32x4 v = {__uint_as_float(lo << 16), __uint_as_float(lo & 0xffff0000u), __uint_as_float(hi << 16), __uint_as_float(hi & 0xffff0000u)};
                    o4[64 * j] = v * rs * gv[j]; } } }
        }
    }
}

extern "C" void kernel_launch(void* const* d_in, const int* in_sizes, int n_in, void* d_out, int out_size, void* d_ws, size_t ws_size, hipStream_t stream) {
    static int grid = 0;
    if (grid == 0) {
        if (n_in != 11 || in_sizes[0] != M_P * DM || out_size != M * DM || ws_size < WS_END) { fprintf(stderr, "kernel_launch: unexpected shapes (n_in %d in0 %d out %d ws %zu)\n", n_in, n_in > 0 ? in_sizes[0] : -1, out_size, ws_size); grid = -1; return; }
        int dev = 0, cus = 0, per_cu = 0;
        if (hipGetDevice(&dev) != hipSuccess || hipDeviceGetAttribute(&cus, hipDeviceAttributeMultiprocessorCount, dev) != hipSuccess) { grid = -1; return; }
        if (hipFuncSetAttribute((const void*)hymba_fwd, hipFuncAttributeMaxDynamicSharedMemorySize, LDS_BYTES) != hipSuccess) { fprintf(stderr, "kernel_launch: hipFuncSetAttribute failed\n"); grid = -1; return; }
        if (hipOccupancyMaxActiveBlocksPerMultiprocessor(&per_cu, (const void*)hymba_fwd, NTHREADS, LDS_BYTES) != hipSuccess || per_cu < 1) { fprintf(stderr, "kernel_launch: occupancy query says %d blocks per CU\n", per_cu); per_cu = 1; }
        (void)hipGetLastError();
        grid = cus;
    }
    if (grid < 0) return;
    Args a{};
    a.xp = (const float*)d_in[0]; a.xs = (const float*)d_in[1]; a.norm_g = (const float*)d_in[2]; a.w_in = (const float*)d_in[3]; a.lambda_qk = (const float*)d_in[4];
    a.subln_g = (const float*)d_in[5]; a.vnorm_g = (const float*)d_in[6]; a.w_s = (const float*)d_in[7]; a.b_s = (const float*)d_in[8]; a.w_out = (const float*)d_in[9]; a.final_g = (const float*)d_in[10];
    a.out = (float*)d_out; a.ws = (unsigned char*)d_ws;
    void* args[] = {&a};
    hipError_t e = hipLaunchCooperativeKernel((const void*)hymba_fwd, dim3(grid), dim3(NTHREADS), args, LDS_BYTES, stream);
    if (e != hipSuccess) fprintf(stderr, "kernel_launch: cooperative launch failed: %s (grid %d)\n", hipGetErrorString(e), grid);
}
```
